# Optimizing an MI355X kernel written in HIP

```python
import jax
import jax.numpy as jnp
from jax import lax
import numpy as np

D_MODEL = 1024
BATCH = 16
SEQ = 2048
DEPTH = 2

GRID_W = 64
CTX_LEN = 256
HEAD_DIM = 64
N_MIXERS = 4
GROUP_W = D_MODEL // N_MIXERS
MIX_W = N_MIXERS * GROUP_W
A_HEADS = GROUP_W // HEAD_DIM
A_KV_HEADS = A_HEADS // 2
WINDOW = 128
WIN_BLOCK = 128
B_HEADS = GROUP_W // HEAD_DIM
NB_ROWS = 8
NB_COLS = 16
NB_KEY_COLS = 2 * NB_COLS
CONV_W = 3
D_HEADS = GROUP_W // HEAD_DIM
SCAN_CHUNK = 64
LB_FLOOR = 1e-20
ROPE_THETA = 10000.0
AXIS_DIM = HEAD_DIM // 2
PEER_HEADS = 8
PEER_NKEYS = 128
PEER_EXPERTS = PEER_NKEYS * PEER_NKEYS
PEER_DQ = D_MODEL // 4
PEER_TOPK = 16
PEER_TOKEN_BLOCK = 128
N_MOD = 6
EPS = 1e-6
MASK_VALUE = -1e30

SPLIT_SIZES = (A_HEADS * HEAD_DIM, A_KV_HEADS * HEAD_DIM, A_KV_HEADS * HEAD_DIM,
               B_HEADS * HEAD_DIM, B_HEADS * HEAD_DIM, B_HEADS * HEAD_DIM,
               GROUP_W, GROUP_W, GROUP_W,
               GROUP_W, GROUP_W, GROUP_W, GROUP_W, GROUP_W)
IN_W = sum(SPLIT_SIZES)

kernel_name = 'hybrid_parallel_mixer_dit_peer'


def _rmsnorm(x, g):
    xf = x.astype(jnp.float32)
    y = xf * lax.rsqrt(jnp.mean(xf * xf, axis=-1, keepdims=True) + EPS)
    return (y * g.astype(jnp.float32)).astype(x.dtype)


def _modulation(cvec, w, b):
    m = jax.nn.silu(cvec) @ w + b
    if m.ndim == 2:
        m = m[:, None, :]
    return jnp.split(m, N_MOD, axis=-1)


def _split_proj(p):
    points = np.cumsum(SPLIT_SIZES)[:-1].tolist()
    return jnp.split(p, points, axis=-1)


def _heads(t):
    return t.reshape(t.shape[0], t.shape[1], -1, HEAD_DIM)


def _axial_angles(L):
    t = jnp.arange(L)
    inv = ROPE_THETA ** (-jnp.arange(0, AXIS_DIM, 2, dtype=jnp.float32) / AXIS_DIM)
    row = (t // GRID_W).astype(jnp.float32)[:, None] * inv
    col = (t % GRID_W).astype(jnp.float32)[:, None] * inv
    return row, col


def _rot_half(x, ang):
    x1, x2 = jnp.split(x, 2, axis=-1)
    c = jnp.cos(ang)[None, :, None, :]
    s = jnp.sin(ang)[None, :, None, :]
    return jnp.concatenate([x1 * c - x2 * s, x1 * s + x2 * c], axis=-1)


def _axial_rope(x, row_ang, col_ang):
    xf = x.astype(jnp.float32)
    xr, xc = jnp.split(xf, 2, axis=-1)
    return jnp.concatenate([_rot_half(xr, row_ang), _rot_half(xc, col_ang)], axis=-1).astype(x.dtype)


def _ctx_attention(q, k, v, sink):
    B, C, H, dh = q.shape
    Hk = k.shape[2]
    G = H // Hk
    qg = q.reshape(B, C, Hk, G, dh)
    s = jnp.einsum('bqhgd,bshd->bhgqs', qg, k).astype(jnp.float32) * dh ** -0.5
    if sink is not None:
        s_sink = jnp.broadcast_to(sink.astype(jnp.float32).reshape(Hk, G)[None, :, :, None, None], (B, Hk, G, C, 1))
        s = jnp.concatenate([s, s_sink], axis=-1)
    p = jax.nn.softmax(s, axis=-1)[..., :C].astype(v.dtype)
    o = jnp.einsum('bhgqs,bshd->bqhgd', p, v)
    return o.reshape(B, C, H * dh)


def _window_attention(q, k, v, k_ctx, v_ctx, sink, row_ang, col_ang):
    B, L, H, dh = q.shape
    G = H // A_KV_HEADS
    C = k_ctx.shape[1]
    nb = L // WIN_BLOCK
    span = WIN_BLOCK + 2 * WINDOW
    scale = dh ** -0.5
    q = _axial_rope(q, row_ang, col_ang)
    k = _axial_rope(k, row_ang, col_ang)
    pad = ((0, 0), (WINDOW, WINDOW), (0, 0), (0, 0))
    idx = jnp.arange(nb)[:, None] * WIN_BLOCK + jnp.arange(span)[None, :]
    kb = jnp.pad(k, pad)[:, idx]
    vb = jnp.pad(v, pad)[:, idx]
    qpos = jnp.arange(nb)[:, None] * WIN_BLOCK + jnp.arange(WIN_BLOCK)[None, :]
    kpos = idx - WINDOW
    mask = ((jnp.abs(qpos[:, :, None] - kpos[:, None, :]) <= WINDOW)
            & (kpos[:, None, :] >= 0) & (kpos[:, None, :] < L))
    qb = q.reshape(B, nb, WIN_BLOCK, A_KV_HEADS, G, dh)
    s_loc = jnp.einsum('bnqhgd,bnshd->bnhgqs', qb, kb).astype(jnp.float32) * scale
    s_loc = jnp.where(mask[None, :, None, None], s_loc, MASK_VALUE)
    s_ctx = jnp.einsum('bnqhgd,bchd->bnhgqc', qb, k_ctx).astype(jnp.float32) * scale
    s_sink = jnp.broadcast_to(sink.astype(jnp.float32).reshape(A_KV_HEADS, G)[None, None, :, :, None, None],
                              s_loc.shape[:-1] + (1,))
    p = jax.nn.softmax(jnp.concatenate([s_loc, s_ctx, s_sink], axis=-1), axis=-1)
    p_loc = p[..., :span].astype(v.dtype)
    p_ctx = p[..., span:span + C].astype(v.dtype)
    o = (jnp.einsum('bnhgqs,bnshd->bnqhgd', p_loc, vb)
         + jnp.einsum('bnhgqc,bchd->bnqhgd', p_ctx, v_ctx))
    return o.reshape(B, L, H * dh)


def _neighbourhood_attention(q, k, v, k_ctx, v_ctx, rpb):
    B, L, H, dh = q.shape
    C = k_ctx.shape[1]
    rows = L // GRID_W
    kr = min(NB_ROWS, rows)
    ncb = GRID_W // NB_COLS
    S = kr * NB_KEY_COLS
    scale = dh ** -0.5
    r = jnp.arange(rows)
    row_idx = jnp.clip(r - kr // 2, 0, rows - kr)[:, None] + jnp.arange(kr)[None, :]
    cblk = jnp.arange(ncb)
    col_idx = (jnp.clip(cblk * NB_COLS - NB_COLS // 2, 0, GRID_W - NB_KEY_COLS)[:, None]
               + jnp.arange(NB_KEY_COLS)[None, :])
    qcol = cblk[:, None] * NB_COLS + jnp.arange(NB_COLS)[None, :]
    win0 = jnp.clip(qcol - NB_COLS // 2, 0, GRID_W - NB_COLS)
    kc = col_idx[:, None, :]
    col_ok = (kc >= win0[:, :, None]) & (kc < win0[:, :, None] + NB_COLS)
    mask = jnp.broadcast_to(col_ok[:, :, None, :], (ncb, NB_COLS, kr, NB_KEY_COLS)).reshape(ncb, NB_COLS, S)
    d_row = row_idx - r[:, None]
    d_col = jnp.clip(kc - qcol[:, :, None], -(NB_COLS - 1), NB_COLS - 1)
    bias = rpb[:, d_row[:, None, None, :, None] + (NB_ROWS - 1), d_col[None, :, :, None, :] + (NB_COLS - 1)]
    bias = bias.reshape(H, rows, ncb, NB_COLS, S).transpose(1, 2, 0, 3, 4).astype(jnp.float32)
    kg = k.reshape(B, rows, GRID_W, H, dh)
    vg = v.reshape(B, rows, GRID_W, H, dh)
    ri = row_idx[:, None, :, None]
    ci = col_idx[None, :, None, :]
    kb = kg[:, ri, ci].reshape(B, rows, ncb, S, H, dh)
    vb = vg[:, ri, ci].reshape(B, rows, ncb, S, H, dh)
    qb = q.reshape(B, rows, ncb, NB_COLS, H, dh)
    s_loc = jnp.einsum('brnqhd,brnshd->brnhqs', qb, kb).astype(jnp.float32) * scale + bias[None]
    s_loc = jnp.where(mask[None, None, :, None], s_loc, MASK_VALUE)
    s_ctx = jnp.einsum('brnqhd,bchd->brnhqc', qb, k_ctx).astype(jnp.float32) * scale
    p = jax.nn.softmax(jnp.concatenate([s_loc, s_ctx], axis=-1), axis=-1)
    p_loc = p[..., :S].astype(v.dtype)
    p_ctx = p[..., S:].astype(v.dtype)
    o = (jnp.einsum('brnhqs,brnshd->brnqhd', p_loc, vb)
         + jnp.einsum('brnhqc,bchd->brnqhd', p_ctx, v_ctx))
    return o.reshape(B, L, H * dh)


def _short_conv(u, w):
    ch = u.shape[-1]
    return lax.conv_general_dilated(u, w[:, None, :].astype(u.dtype), window_strides=(1,),
                                    padding=[(CONV_W // 2, CONV_W // 2)],
                                    dimension_numbers=('NWC', 'WIO', 'NWC'),
                                    feature_group_count=ch)


def _hgrn2_gates(z, lb):
    log_lb = jnp.log(jnp.maximum(lb, LB_FLOOR))
    logf = jnp.logaddexp(log_lb, jnp.log1p(-lb) + jax.nn.log_sigmoid(z.astype(jnp.float32)))
    return -jnp.expm1(logf), logf


def _hgrn2_scan(q, k, v, logf, s0):
    B, L, H, _ = q.shape
    dv = v.shape[-1]
    n = L // SCAN_CHUNK

    def chunks(a):
        return a.astype(jnp.float32).reshape(B, n, SCAN_CHUNK, H, a.shape[-1]).transpose(1, 0, 3, 2, 4)

    tril = jnp.tril(jnp.ones((SCAN_CHUNK, SCAN_CHUNK), dtype=bool))[:, :, None]

    def step(S, inp):
        qc, kc, vc, lc = inp
        G = jnp.cumsum(lc, axis=2)
        diff = G[:, :, :, None, :] - G[:, :, None, :, :]
        decay = jnp.where(tril, jnp.exp(jnp.where(tril, diff, 0.0)), 0.0)
        attn = jnp.einsum('bhid,bhjd,bhijd->bhij', qc, kc, decay)
        o = jnp.einsum('bhij,bhjv->bhiv', attn, vc) + jnp.einsum('bhid,bhdv->bhiv', qc * jnp.exp(G), S)
        G_end = G[:, :, -1:, :]
        S = (jnp.exp(G_end[:, :, 0, :, None]) * S
             + jnp.einsum('bhjd,bhjv->bhdv', kc * jnp.exp(G_end - G), vc))
        return S, o

    S, o = lax.scan(step, s0, (chunks(q), chunks(k), chunks(v), chunks(logf)))
    o = o.transpose(1, 0, 3, 2, 4).reshape(B, L, H, dv)
    return o.astype(v.dtype), S


def _hgrn2_bidir(q, v, zf, zb, q_c, v_c, zf_c, zb_c, lb):
    B = q.shape[0]
    lb = lb.reshape(D_HEADS, HEAD_DIM)
    s0 = jnp.zeros((B, D_HEADS, HEAD_DIM, HEAD_DIM), jnp.float32)
    rev = lambda a: a[:, ::-1]
    kf, lf = _hgrn2_gates(zf, lb)
    kf_c, lf_c = _hgrn2_gates(zf_c, lb)
    kb, lbw = _hgrn2_gates(zb, lb)
    kb_c, lbw_c = _hgrn2_gates(zb_c, lb)
    oc_f, s_f = _hgrn2_scan(q_c, kf_c, v_c, lf_c, s0)
    o_f, _ = _hgrn2_scan(q, kf, v, lf, s_f)
    oc_b, s_b = _hgrn2_scan(rev(q_c), rev(kb_c), rev(v_c), rev(lbw_c), s0)
    o_b, _ = _hgrn2_scan(rev(q), rev(kb), rev(v), rev(lbw), s_b)
    return o_f + rev(o_b), oc_f + rev(oc_b)


def _merge_groups(parts, gnorm):
    gains = jnp.split(gnorm, N_MIXERS)
    return jnp.concatenate([_rmsnorm(p, g) for p, g in zip(parts, gains)], axis=-1)


def _mixers(hx, hc, w_in, conv_w, sink, rpb, lb, gnorm, w_out, row_ang, col_ang, with_ctx):
    B, L, _ = hx.shape
    C = hc.shape[1]
    (aq, ak, av, bq, bk, bv, cx, cb, cc, dq, dzf, dzb, di, dg) = _split_proj(hx @ w_in)
    (aq_c, ak_c, av_c, bq_c, bk_c, bv_c, cx_c, cb_c, cc_c, dq_c, dzf_c, dzb_c, di_c, dg_c) = _split_proj(hc @ w_in)
    ak_c, av_c, bk_c, bv_c = _heads(ak_c), _heads(av_c), _heads(bk_c), _heads(bv_c)
    y_a = _window_attention(_heads(aq), _heads(ak), _heads(av), ak_c, av_c, sink, row_ang, col_ang)
    y_b = _neighbourhood_attention(_heads(bq), _heads(bk), _heads(bv), bk_c, bv_c, rpb)
    y_c = cb * _short_conv(cc * cx, conv_w)
    o_d, o_dc = _hgrn2_bidir(_heads(dq), _heads(di), _heads(dzf), _heads(dzb),
                             _heads(dq_c), _heads(di_c), _heads(dzf_c), _heads(dzb_c), lb)
    y_d = o_d.reshape(B, L, GROUP_W) * jax.nn.silu(dg)
    y = _merge_groups((y_a, y_b, y_c, y_d), gnorm) @ w_out
    if not with_ctx:
        return y, None
    yc_a = _ctx_attention(_heads(aq_c), ak_c, av_c, sink)
    yc_b = _ctx_attention(_heads(bq_c), bk_c, bv_c, None)
    yc_c = cb_c * _short_conv(cc_c * cx_c, conv_w)
    yc_d = o_dc.reshape(B, C, GROUP_W) * jax.nn.silu(dg_c)
    yc = _merge_groups((yc_a, yc_b, yc_c, yc_d), gnorm) @ w_out
    return y, yc


def _peer(h, w_q, sub_k1, sub_k2, u, v):
    T, D = h.shape
    q = (h @ w_q).reshape(T, PEER_HEADS, 2, PEER_DQ // 2)
    s1 = jnp.einsum('thd,kd->thk', q[:, :, 0], sub_k1)
    s2 = jnp.einsum('thd,kd->thk', q[:, :, 1], sub_k2)
    v1, i1 = lax.top_k(s1, PEER_TOPK)
    v2, i2 = lax.top_k(s2, PEER_TOPK)
    cand_s = (v1[..., :, None] + v2[..., None, :]).reshape(T, PEER_HEADS, PEER_TOPK * PEER_TOPK)
    cand_i = (i1[..., :, None] * PEER_NKEYS + i2[..., None, :]).reshape(T, PEER_HEADS, PEER_TOPK * PEER_TOPK)
    top_s, pos = lax.top_k(cand_s, PEER_TOPK)
    idx = jnp.take_along_axis(cand_i, pos, axis=-1)
    gate = jax.nn.softmax(top_s.astype(jnp.float32), axis=-1).astype(h.dtype)
    E = PEER_HEADS * PEER_TOPK
    nblk = T // PEER_TOKEN_BLOCK

    def block(args):
        hb, ib, gb = args
        act = jax.nn.gelu(jnp.einsum('td,ted->te', hb, u[ib])) * gb
        return jnp.einsum('te,ted->td', act, v[ib])

    out = lax.map(block, (h.reshape(nblk, PEER_TOKEN_BLOCK, D),
                          idx.reshape(nblk, PEER_TOKEN_BLOCK, E),
                          gate.reshape(nblk, PEER_TOKEN_BLOCK, E)))
    return out.reshape(T, D)


def setup_inputs(seed: int = 0) -> dict:
    key = jax.random.key(seed)
    ks = jax.random.split(key, 21)
    nrm = lambda k, shape, s: jax.random.normal(k, shape, jnp.float32) * s
    return {
        'x': nrm(ks[0], (BATCH, SEQ, D_MODEL), 1.0),
        'c': nrm(ks[1], (BATCH, D_MODEL), 1.0),
        'ctx': nrm(ks[2], (BATCH, CTX_LEN, D_MODEL), 1.0),
        'c_ctx': nrm(ks[3], (D_MODEL,), 1.0),
        'w_mod': nrm(ks[4], (DEPTH, D_MODEL, N_MOD * D_MODEL), 0.5 * D_MODEL ** -0.5),
        'b_mod': nrm(ks[5], (DEPTH, N_MOD * D_MODEL), 0.02),
        'norm_mix': 1.0 + nrm(ks[6], (DEPTH, D_MODEL), 0.02),
        'norm_ffn': 1.0 + nrm(ks[7], (DEPTH, D_MODEL), 0.02),
        'w_in': nrm(ks[8], (DEPTH, D_MODEL, IN_W), D_MODEL ** -0.5),
        'conv_w': nrm(ks[9], (DEPTH, CONV_W, GROUP_W), CONV_W ** -0.5),
        'attn_sink': nrm(ks[10], (DEPTH, A_HEADS), 0.5),
        'na_rpb': nrm(ks[11], (DEPTH, B_HEADS, 2 * NB_ROWS - 1, 2 * NB_COLS - 1), 0.1),
        'lb_logits': nrm(ks[12], (DEPTH, GROUP_W), 0.5),
        'group_norm': 1.0 + nrm(ks[13], (DEPTH, MIX_W), 0.02),
        'w_out': nrm(ks[14], (DEPTH, MIX_W, D_MODEL), MIX_W ** -0.5),
        'peer_wq': nrm(ks[15], (DEPTH, D_MODEL, PEER_HEADS * PEER_DQ), D_MODEL ** -0.5),
        'peer_k1': nrm(ks[16], (DEPTH, PEER_NKEYS, PEER_DQ // 2), (PEER_DQ // 2) ** -0.5),
        'peer_k2': nrm(ks[17], (DEPTH, PEER_NKEYS, PEER_DQ // 2), (PEER_DQ // 2) ** -0.5),
        'peer_u': nrm(ks[18], (DEPTH, PEER_EXPERTS, D_MODEL), D_MODEL ** -0.5),
        'peer_v': nrm(ks[19], (DEPTH, PEER_EXPERTS, D_MODEL), PEER_HEADS ** -0.5),
        'final_norm': 1.0 + nrm(ks[20], (D_MODEL,), 0.02),
    }


def reference(x, c, ctx, c_ctx, w_mod, b_mod, norm_mix, norm_ffn, w_in, conv_w, attn_sink, na_rpb,
              lb_logits, group_norm, w_out, peer_wq, peer_k1, peer_k2, peer_u, peer_v, final_norm):
    B, L, D = x.shape
    C = ctx.shape[1]
    row_ang, col_ang = _axial_angles(L)
    lb_soft = jax.nn.softmax(lb_logits.astype(jnp.float32), axis=0)
    lower_bounds = jnp.cumsum(lb_soft, axis=0) - lb_soft[0:1]
    for l in range(DEPTH):
        last = l == DEPTH - 1
        sh1, sc1, g1, sh2, sc2, g2 = _modulation(c, w_mod[l], b_mod[l])
        sh1c, sc1c, g1c, sh2c, sc2c, g2c = _modulation(c_ctx, w_mod[l], b_mod[l])
        hx = _rmsnorm(x, norm_mix[l]) * (1 + sc1) + sh1
        hc = _rmsnorm(ctx, norm_mix[l]) * (1 + sc1c) + sh1c
        y, yc = _mixers(hx, hc, w_in[l], conv_w[l], attn_sink[l], na_rpb[l], lower_bounds[l],
                        group_norm[l], w_out[l], row_ang, col_ang, not last)
        x = x + g1 * y
        hx2 = _rmsnorm(x, norm_ffn[l]) * (1 + sc2) + sh2
        peer_args = (peer_wq[l], peer_k1[l], peer_k2[l], peer_u[l], peer_v[l])
        if last:
            x = x + g2 * _peer(hx2.reshape(B * L, D), *peer_args).reshape(B, L, D)
        else:
            ctx = ctx + g1c * yc
            hc2 = _rmsnorm(ctx, norm_ffn[l]) * (1 + sc2c) + sh2c
            f = _peer(jnp.concatenate([hc2, hx2], axis=1).reshape(B * (C + L), D), *peer_args)
            f = f.reshape(B, C + L, D)
            ctx = ctx + g2c * f[:, :C]
            x = x + g2 * f[:, C:]
    return _rmsnorm(x, final_norm)
```

```cpp
#ifndef HOST_EMU
#include <hip/hip_runtime.h>
#define DEV __device__ __forceinline__
#else
#include <cmath>
#include <cstring>
#include <cstdint>
#include <cstdio>
#define DEV inline
#define __global__
#define __device__
struct float4 { float x, y, z, w; };
struct ushort4 { unsigned short x, y, z, w; };
#endif
#include <cstddef>
#include <cstring>

#ifndef CFG_BATCH
#define CFG_BATCH 16
#endif
#ifndef CFG_SEQ
#define CFG_SEQ 2048
#endif
#ifndef CFG_CTX
#define CFG_CTX 256
#endif
#ifndef CFG_NKEYS
#define CFG_NKEYS 128
#endif

typedef unsigned short bf16_t;

constexpr int BATCH = CFG_BATCH, SEQ = CFG_SEQ, CTXL = CFG_CTX, DM = 1024, DEPTH = 2;
constexpr int TPB = SEQ + CTXL;
constexpr int NTOK = BATCH * TPB;
constexpr int NLAT = BATCH * SEQ;
constexpr int INW = 3328, NMODW = 6144, GRIDW = 64, ROWS = SEQ / GRIDW;
constexpr int NKEYS = CFG_NKEYS, NEXP = NKEYS * NKEYS, PHEADS = 8, PQW = 2048, PTOPK = 16, PE = PHEADS * PTOPK;
constexpr int WTL = (INW + DM + PQW) * DM;
constexpr int C_AQ = 0, C_AK = 256, C_AV = 384, C_BQ = 512, C_BK = 768, C_BV = 1024, C_CX = 1280, C_CB = 1536, C_CC = 1792,
              C_DQ = 2048, C_DZF = 2304, C_DZB = 2560, C_DI = 2816, C_DG = 3072;
constexpr float EPS = 1e-6f, MASKV = -1e30f;

struct Params {
    const float *x, *c, *ctx, *c_ctx, *w_mod, *b_mod, *norm_mix, *norm_ffn, *w_in, *conv_w, *attn_sink, *na_rpb, *lb_logits,
                *group_norm, *w_out, *peer_wq, *peer_k1, *peer_k2, *peer_u, *peer_v, *final_norm;
    float* out;
    float* MOD;
    float* ROPE;
    bf16_t* WT;
    bf16_t* KB;
    float* CTXR;
    bf16_t* H;
    bf16_t* P;
    bf16_t* Y;
    float* OD;
    bf16_t* Q;
    float* CANDV;
    int* CANDI;
    bf16_t* UB;
    bf16_t* VB;
    int* IDX;
    float* GATE;
};

DEV float u2f(unsigned u) { float f; memcpy(&f, &u, 4); return f; }
DEV unsigned f2u(float f) { unsigned u; memcpy(&u, &f, 4); return u; }
DEV bf16_t f2bf(float f) { unsigned u = f2u(f); u += 0x7fffu + ((u >> 16) & 1u); return (bf16_t)(u >> 16); }
DEV float bf2f(bf16_t h) { return u2f(((unsigned)h) << 16); }
DEV float sigmoidf_(float x) { return 1.0f / (1.0f + expf(-x)); }
DEV float siluf_(float x) { return x * sigmoidf_(x); }
DEV float gelu_tanh_(float x) { const float u = 0.7978845608028654f * (x + 0.044715f * x * x * x); const float t = 1.0f - 2.0f / (1.0f + expf(2.0f * u)); return 0.5f * x * (1.0f + t); }
DEV int clampi(int v, int lo, int hi) { return v < lo ? lo : (v > hi ? hi : v); }

DEV const float* resid_in(const Params& p, int layer, int row) {
    const int b = row / TPB, pp = row % TPB;
    if (pp < CTXL) return (layer == 0 ? p.ctx : p.CTXR) + ((size_t)b * CTXL + pp) * DM;
    return (layer == 0 ? p.x : p.out) + ((size_t)b * SEQ + (pp - CTXL)) * DM;
}
DEV float* resid_out(const Params& p, int row) {
    const int b = row / TPB, pp = row % TPB;
    if (pp < CTXL) return p.CTXR + ((size_t)b * CTXL + pp) * DM;
    return p.out + ((size_t)b * SEQ + (pp - CTXL)) * DM;
}
DEV const float* mod_row(const Params& p, int layer, int row) {
    const int b = row / TPB, pp = row % TPB;
    return p.MOD + ((size_t)layer * 17 + (pp < CTXL ? 16 : b)) * NMODW;
}
DEV int lat_row(int i) { return (i / SEQ) * TPB + CTXL + (i % SEQ); }

DEV void st_mod(const Params& p, long gtid, long gsz) {
    for (long i = gtid; i < (long)DEPTH * 17 * NMODW; i += gsz) {
        const int n = (int)(i % NMODW), r = (int)((i / NMODW) % 17), l = (int)(i / ((long)NMODW * 17));
        const float* cv = (r < 16) ? (p.c + (size_t)(r < BATCH ? r : 0) * DM) : p.c_ctx;
        const float* w = p.w_mod + (size_t)l * DM * NMODW + n;
        float acc = 0.f;
        for (int k = 0; k < DM; ++k) acc += siluf_(cv[k]) * w[(size_t)k * NMODW];
        p.MOD[i] = acc + p.b_mod[(size_t)l * NMODW + n];
    }
}
DEV void st_wt(const Params& p, long gtid, long gsz) {
    for (long i = gtid; i < (long)DEPTH * WTL; i += gsz) {
        const int l = (int)(i / WTL); const long e = i % WTL; const int n = (int)(e / DM), k = (int)(e % DM);
        float v;
        if (n < INW) v = p.w_in[((size_t)l * DM + k) * INW + n];
        else if (n < INW + DM) v = p.w_out[((size_t)l * DM + k) * DM + (n - INW)];
        else v = p.peer_wq[((size_t)l * DM + k) * PQW + (n - INW - DM)];
        p.WT[i] = f2bf(v);
    }
    for (long i = gtid; i < (long)DEPTH * 2 * NKEYS * 128; i += gsz) {
        const int l = (int)(i / (2 * NKEYS * 128)); const int e = (int)(i % (2 * NKEYS * 128)); const int hf = e / (NKEYS * 128), r = e % (NKEYS * 128);
        p.KB[i] = f2bf((hf ? p.peer_k2 : p.peer_k1)[(size_t)l * NKEYS * 128 + r]);
    }
    for (long i = gtid; i < 64 * 16; i += gsz) {
        const int pos = (int)(i / 16), f = (int)(i % 16);
        const float inv = powf(10000.0f, -((float)(2 * f)) / 32.0f);
        const float ang = (float)pos * inv;
        p.ROPE[i] = cosf(ang); p.ROPE[1024 + i] = sinf(ang);
    }
}
DEV void st_uvconv(const Params& p, int layer, long gtid, long gsz) {
    const float* u = p.peer_u + (size_t)layer * NEXP * DM; const float* v = p.peer_v + (size_t)layer * NEXP * DM;
    for (long i = gtid; i < (long)NEXP * DM / 4; i += gsz) {
        const float4 a = ((const float4*)u)[i], b = ((const float4*)v)[i];
        ushort4 ua, ub; ua.x = f2bf(a.x); ua.y = f2bf(a.y); ua.z = f2bf(a.z); ua.w = f2bf(a.w); ub.x = f2bf(b.x); ub.y = f2bf(b.y); ub.z = f2bf(b.z); ub.w = f2bf(b.w);
        ((ushort4*)p.UB)[i] = ua; ((ushort4*)p.VB)[i] = ub;
    }
}

DEV void st_norm_naive(const Params& p, int layer, int which, bool lat_only, long gtid, long gsz) {
    const int nrows = lat_only ? NLAT : NTOK;
    for (long i = gtid; i < nrows; i += gsz) {
        const int row = lat_only ? lat_row((int)i) : (int)i;
        const float* xr = resid_in(p, (which == 0) ? layer : 1, row);
        const float* m = mod_row(p, layer, row);
        const float* g = (which ? p.norm_ffn : p.norm_mix) + (size_t)layer * DM;
        const float* sh = m + (which ? 3 : 0) * DM; const float* sc = m + (which ? 4 : 1) * DM;
        float ss = 0.f;
        for (int k = 0; k < DM; ++k) ss += xr[k] * xr[k];
        const float rs = 1.0f / sqrtf(ss * (1.0f / DM) + EPS);
        bf16_t* h = p.H + (size_t)row * DM;
        for (int k = 0; k < DM; ++k) h[k] = f2bf(xr[k] * rs * g[k] * (1.0f + sc[k]) + sh[k]);
    }
}

DEV void gemm_epi(const Params& p, int layer, int mode, int row, int col, float acc) {
    if (mode == 0) p.P[(size_t)row * INW + col] = f2bf(acc);
    else if (mode == 2) p.Q[(size_t)row * PQW + col] = f2bf(acc);
    else { const float g1 = mod_row(p, layer, row)[2 * DM + col]; resid_out(p, row)[col] = resid_in(p, layer, row)[col] + g1 * acc; }
}
DEV void gemm_cfg(const Params& p, int layer, int mode, const bf16_t*& Bt, int& N) {
    const bf16_t* w = p.WT + (size_t)layer * WTL;
    if (mode == 0) { Bt = w; N = INW; } else if (mode == 1) { Bt = w + (size_t)INW * DM; N = DM; } else { Bt = w + (size_t)(INW + DM) * DM; N = PQW; }
}
DEV void st_gemm_naive(const Params& p, int layer, int mode, bool lat_only, long gtid, long gsz) {
    const bf16_t* Bt; int N; gemm_cfg(p, layer, mode, Bt, N);
    const long nrows = lat_only ? NLAT : NTOK;
    for (long i = gtid; i < nrows * N; i += gsz) {
        const int col = (int)(i % N); const int r = (int)(i / N); const int row = lat_only ? lat_row(r) : r;
        const bf16_t* a = p.H + (size_t)row * DM; const bf16_t* b = Bt + (size_t)col * DM;
        float acc = 0.f;
        for (int k = 0; k < DM; ++k) acc += bf2f(a[k]) * bf2f(b[k]);
        gemm_epi(p, layer, mode, row, col, acc);
    }
}

DEV void rope_load(const Params& p, const bf16_t* src, int t, float* dst) {
    const float* cs = p.ROPE; const float* sn = p.ROPE + 1024; const int r = t / GRIDW, c = t % GRIDW;
#pragma unroll
    for (int i = 0; i < 16; ++i) {
        const float x1 = bf2f(src[i]), x2 = bf2f(src[16 + i]); const float cr = cs[r * 16 + i], sr = sn[r * 16 + i];
        dst[i] = x1 * cr - x2 * sr; dst[16 + i] = x1 * sr + x2 * cr;
        const float y1 = bf2f(src[32 + i]), y2 = bf2f(src[48 + i]); const float cc = cs[c * 16 + i], sc = sn[c * 16 + i];
        dst[32 + i] = y1 * cc - y2 * sc; dst[48 + i] = y1 * sc + y2 * cc;
    }
}
DEV float rope_dot(const Params& p, const float* q, const bf16_t* src, int t) {
    const float* cs = p.ROPE; const float* sn = p.ROPE + 1024; const int r = t / GRIDW, c = t % GRIDW; float acc = 0.f;
#pragma unroll
    for (int i = 0; i < 16; ++i) {
        const float x1 = bf2f(src[i]), x2 = bf2f(src[16 + i]); const float cr = cs[r * 16 + i], sr = sn[r * 16 + i];
        acc += q[i] * (x1 * cr - x2 * sr) + q[16 + i] * (x1 * sr + x2 * cr);
        const float y1 = bf2f(src[32 + i]), y2 = bf2f(src[48 + i]); const float cc = cs[c * 16 + i], sc = sn[c * 16 + i];
        acc += q[32 + i] * (y1 * cc - y2 * sc) + q[48 + i] * (y1 * sc + y2 * cc);
    }
    return acc;
}
struct OnlineSm { float m, l; float o[64]; };
DEV void osm_init(OnlineSm& s) { s.m = MASKV; s.l = 0.f;
#pragma unroll
    for (int d = 0; d < 64; ++d) s.o[d] = 0.f; }
DEV void osm_add(OnlineSm& s, float sc, const bf16_t* vrow) {
    const float mn = sc > s.m ? sc : s.m; const float a = expf(s.m - mn), pe = expf(sc - mn);
    s.l = s.l * a + pe; s.m = mn;
#pragma unroll
    for (int d = 0; d < 64; ++d) s.o[d] = s.o[d] * a + pe * bf2f(vrow[d]);
}
DEV void osm_sink(OnlineSm& s, float sk) { const float mn = sk > s.m ? sk : s.m; const float a = expf(s.m - mn);
    s.l = s.l * a + expf(sk - mn); s.m = mn;
#pragma unroll
    for (int d = 0; d < 64; ++d) s.o[d] *= a; }
DEV void osm_store(const OnlineSm& s, bf16_t* dst) { const float inv = 1.0f / s.l;
#pragma unroll
    for (int d = 0; d < 64; ++d) dst[d] = f2bf(s.o[d] * inv); }

DEV void st_attnA_naive(const Params& p, int layer, long gtid, long gsz) {
    for (long i = gtid; i < (long)BATCH * 4 * SEQ; i += gsz) {
        const int t = (int)(i % SEQ), h = (int)((i / SEQ) % 4), b = (int)(i / ((long)SEQ * 4)); const int hk = h >> 1;
        const bf16_t* Pb = p.P + (size_t)b * TPB * INW;
        float q[64]; rope_load(p, Pb + (size_t)(CTXL + t) * INW + C_AQ + h * 64, t, q);
        OnlineSm s; osm_init(s);
        const int k0 = t - 128 < 0 ? 0 : t - 128, k1 = t + 128 > SEQ - 1 ? SEQ - 1 : t + 128;
        for (int kp = k0; kp <= k1; ++kp) {
            const bf16_t* kr = Pb + (size_t)(CTXL + kp) * INW;
            const float sc = rope_dot(p, q, kr + C_AK + hk * 64, kp);
            osm_add(s, sc * 0.125f, kr + C_AV + hk * 64);
        }
        for (int kc = 0; kc < CTXL; ++kc) {
            const bf16_t* kr = Pb + (size_t)kc * INW; float sc = 0.f;
#pragma unroll
            for (int d = 0; d < 64; ++d) sc += q[d] * bf2f(kr[C_AK + hk * 64 + d]);
            osm_add(s, sc * 0.125f, kr + C_AV + hk * 64);
        }
        osm_sink(s, p.attn_sink[layer * 4 + h]);
        osm_store(s, p.Y + ((size_t)b * TPB + CTXL + t) * 512 + h * 64);
    }
}
DEV void st_attnB_naive(const Params& p, int layer, long gtid, long gsz) {
    for (long i = gtid; i < (long)BATCH * 4 * SEQ; i += gsz) {
        const int t = (int)(i % SEQ), h = (int)((i / SEQ) % 4), b = (int)(i / ((long)SEQ * 4));
        const bf16_t* Pb = p.P + (size_t)b * TPB * INW;
        const int r = t / GRIDW, qc = t % GRIDW; const int rs = clampi(r - 4, 0, ROWS - 8), w0 = clampi(qc - 8, 0, GRIDW - 16);
        const float* rpb = p.na_rpb + ((size_t)layer * 4 + h) * 15 * 31;
        float q[64];
#pragma unroll
        for (int d = 0; d < 64; ++d) q[d] = bf2f(Pb[(size_t)(CTXL + t) * INW + C_BQ + h * 64 + d]);
        OnlineSm s; osm_init(s);
        for (int kr_ = rs; kr_ < rs + 8; ++kr_)
            for (int kc = w0; kc < w0 + 16; ++kc) {
                const bf16_t* kr = Pb + (size_t)(CTXL + kr_ * GRIDW + kc) * INW; float sc = 0.f;
#pragma unroll
                for (int d = 0; d < 64; ++d) sc += q[d] * bf2f(kr[C_BK + h * 64 + d]);
                osm_add(s, sc * 0.125f + rpb[(kr_ - r + 7) * 31 + (kc - qc + 15)], kr + C_BV + h * 64);
            }
        for (int kc = 0; kc < CTXL; ++kc) {
            const bf16_t* kr = Pb + (size_t)kc * INW; float sc = 0.f;
#pragma unroll
            for (int d = 0; d < 64; ++d) sc += q[d] * bf2f(kr[C_BK + h * 64 + d]);
            osm_add(s, sc * 0.125f, kr + C_BV + h * 64);
        }
        osm_store(s, p.Y + ((size_t)b * TPB + CTXL + t) * 512 + 256 + h * 64);
    }
}
DEV void st_attnC_naive(const Params& p, int layer, long gtid, long gsz) {
    for (long i = gtid; i < (long)BATCH * 2 * 4 * CTXL; i += gsz) {
        const int tq = (int)(i % CTXL), h = (int)((i / CTXL) % 4), wh = (int)((i / (CTXL * 4)) % 2), b = (int)(i / ((long)CTXL * 8));
        const bf16_t* Pb = p.P + (size_t)b * TPB * INW;
        const int qcol = wh ? C_BQ + h * 64 : C_AQ + h * 64, kcol = wh ? C_BK + h * 64 : C_AK + (h >> 1) * 64, vcol = wh ? C_BV + h * 64 : C_AV + (h >> 1) * 64;
        float q[64];
#pragma unroll
        for (int d = 0; d < 64; ++d) q[d] = bf2f(Pb[(size_t)tq * INW + qcol + d]);
        OnlineSm s; osm_init(s);
        for (int kc = 0; kc < CTXL; ++kc) {
            const bf16_t* kr = Pb + (size_t)kc * INW; float sc = 0.f;
#pragma unroll
            for (int d = 0; d < 64; ++d) sc += q[d] * bf2f(kr[kcol + d]);
            osm_add(s, sc * 0.125f, kr + vcol);
        }
        if (!wh) osm_sink(s, p.attn_sink[layer * 4 + h]);
        osm_store(s, p.Y + ((size_t)b * TPB + tq) * 512 + wh * 256 + h * 64);
    }
}
DEV float hgrn_lb(const Params& p, int layer, int ch) { if (layer == 0) return 0.f; return sigmoidf_(p.lb_logits[256 + ch] - p.lb_logits[ch]); }
DEV void st_hgrn_naive(const Params& p, int layer, long gtid, long gsz) {
    for (long i = gtid; i < (long)BATCH * 4 * 2 * 64; i += gsz) {
        const int v = (int)(i % 64), dir = (int)((i / 64) % 2), h = (int)((i / 128) % 4), b = (int)(i / 512);
        const bf16_t* Pb = p.P + (size_t)b * TPB * INW; const int zc = (dir ? C_DZB : C_DZF) + h * 64;
        float S[64], lb[64];
#pragma unroll
        for (int d = 0; d < 64; ++d) { S[d] = 0.f; lb[d] = hgrn_lb(p, layer, h * 64 + d); }
        float* od = p.OD + ((size_t)dir * NTOK + (size_t)b * TPB) * 256 + h * 64 + v;
        for (int st = 0; st < TPB; ++st) {
            int pp;
            if (st < CTXL) pp = dir ? CTXL - 1 - st : st; else { const int t = st - CTXL; pp = CTXL + (dir ? SEQ - 1 - t : t); }
            const bf16_t* pr = Pb + (size_t)pp * INW; const float vv = bf2f(pr[C_DI + h * 64 + v]); float o = 0.f;
#pragma unroll
            for (int d = 0; d < 64; ++d) {
                const float z = bf2f(pr[zc + d]); const float sg = sigmoidf_(z);
                const float f = lb[d] + (1.0f - lb[d]) * sg, k = (1.0f - lb[d]) * (1.0f - sg);
                S[d] = f * S[d] + k * vv; o += bf2f(pr[C_DQ + h * 64 + d]) * S[d];
            }
            od[(size_t)pp * 256] = o;
        }
    }
}
DEV float mixC_val(const Params& p, int layer, int row, int ch) {
    const int pp = row % TPB; const bool isctx = pp < CTXL; const int lo = isctx ? 0 : CTXL, hi = isctx ? CTXL - 1 : TPB - 1;
    const bf16_t* pr = p.P + (size_t)row * INW; const float* w = p.conv_w + (size_t)layer * 3 * 256;
    float acc = 0.f;
#pragma unroll
    for (int j = 0; j < 3; ++j) { const int q = pp + j - 1; if (q >= lo && q <= hi) { const bf16_t* nr = pr + (ptrdiff_t)(j - 1) * INW; acc += w[j * 256 + ch] * bf2f(nr[C_CC + ch]) * bf2f(nr[C_CX + ch]); } }
    return bf2f(pr[C_CB + ch]) * acc;
}
DEV float mixD_val(const Params& p, int row, int ch) {
    const float o = p.OD[(size_t)row * 256 + ch] + p.OD[((size_t)NTOK + row) * 256 + ch];
    return o * siluf_(bf2f(p.P[(size_t)row * INW + C_DG + ch]));
}
DEV void st_merge_naive(const Params& p, int layer, bool lat_only, long gtid, long gsz) {
    const long nrows = lat_only ? NLAT : NTOK;
    for (long i = gtid; i < nrows * 4; i += gsz) {
        const int g = (int)(i % 4); const int r = (int)(i / 4); const int row = lat_only ? lat_row(r) : r;
        float ss = 0.f;
        for (int ch = 0; ch < 256; ++ch) { const float y = g < 2 ? bf2f(p.Y[(size_t)row * 512 + g * 256 + ch]) : (g == 2 ? mixC_val(p, layer, row, ch) : mixD_val(p, row, ch)); ss += y * y; }
        const float rs = 1.0f / sqrtf(ss * (1.0f / 256.0f) + EPS); const float* gn = p.group_norm + (size_t)layer * DM + g * 256;
        for (int ch = 0; ch < 256; ++ch) { const float y = g < 2 ? bf2f(p.Y[(size_t)row * 512 + g * 256 + ch]) : (g == 2 ? mixC_val(p, layer, row, ch) : mixD_val(p, row, ch));
            p.H[(size_t)row * DM + g * 256 + ch] = f2bf(y * rs * gn[ch]); }
    }
}

#define TOPK_INS(V, I, xv, xi) { float x_ = (xv); int j_ = (xi); _Pragma("unroll") for (int q_ = 0; q_ < 16; ++q_) { if (x_ > V[q_]) { const float tv_ = V[q_]; const int ti_ = I[q_]; V[q_] = x_; I[q_] = j_; x_ = tv_; j_ = ti_; } } }
DEV void st_peer_scores_naive(const Params& p, int layer, bool lat_only, long gtid, long gsz) {
    const long nrows = lat_only ? NLAT : NTOK;
    for (long i = gtid; i < nrows * 16; i += gsz) {
        const int hh = (int)(i % 16); const int r = (int)(i / 16); const int row = lat_only ? lat_row(r) : r; const int hf = hh & 1;
        const bf16_t* q = p.Q + (size_t)row * PQW + hh * 128; const bf16_t* kb = p.KB + ((size_t)layer * 2 + hf) * NKEYS * 128;
        float V[16]; int I[16];
#pragma unroll
        for (int j = 0; j < 16; ++j) { V[j] = -3.0e38f; I[j] = 0; }
        for (int k = 0; k < NKEYS; ++k) { float s = 0.f; for (int d = 0; d < 128; ++d) s += bf2f(q[d]) * bf2f(kb[(size_t)k * 128 + d]); TOPK_INS(V, I, s, k); }
#pragma unroll
        for (int j = 0; j < 16; ++j) { p.CANDV[((size_t)row * 16 + hh) * 16 + j] = V[j]; p.CANDI[((size_t)row * 16 + hh) * 16 + j] = I[j]; }
    }
}
DEV void st_peer_combine(const Params& p, bool lat_only, long gtid, long gsz) {
    const long nrows = lat_only ? NLAT : NTOK;
    for (long i = gtid; i < nrows * 8; i += gsz) {
        const int h = (int)(i % 8); const int r = (int)(i / 8); const int row = lat_only ? lat_row(r) : r;
        const float* v1 = p.CANDV + ((size_t)row * 16 + h * 2) * 16; const float* v2 = v1 + 16; const int* i1 = p.CANDI + ((size_t)row * 16 + h * 2) * 16; const int* i2 = i1 + 16;
        float a1[16], a2[16]; int b1[16], b2[16];
#pragma unroll
        for (int j = 0; j < 16; ++j) { a1[j] = v1[j]; a2[j] = v2[j]; b1[j] = i1[j]; b2[j] = i2[j]; }
        float V[16]; int I[16];
#pragma unroll
        for (int j = 0; j < 16; ++j) { V[j] = -3.0e38f; I[j] = 0; }
#pragma unroll
        for (int a = 0; a < 16; ++a)
#pragma unroll
            for (int b = 0; b < 16; ++b) if ((a + 1) * (b + 1) <= 16) TOPK_INS(V, I, a1[a] + a2[b], b1[a] * NKEYS + b2[b]);
        float sum = 0.f, e[16];
#pragma unroll
        for (int j = 0; j < 16; ++j) { e[j] = expf(V[j] - V[0]); sum += e[j]; }
        const float inv = 1.0f / sum;
#pragma unroll
        for (int j = 0; j < 16; ++j) { p.IDX[(size_t)row * PE + h * 16 + j] = I[j]; p.GATE[(size_t)row * PE + h * 16 + j] = e[j] * inv; }
    }
}
DEV void st_peer_act_naive(const Params& p, bool lat_only, long gtid, long gsz) {
    const long nrows = lat_only ? NLAT : NTOK;
    for (long i = gtid; i < nrows * PE; i += gsz) {
        const int e = (int)(i % PE); const int r = (int)(i / PE); const int row = lat_only ? lat_row(r) : r;
        const bf16_t* h = p.H + (size_t)row * DM; const bf16_t* u = p.UB + (size_t)p.IDX[(size_t)row * PE + e] * DM;
        float s = 0.f;
        for (int k = 0; k < DM; ++k) s += bf2f(h[k]) * bf2f(u[k]);
        p.GATE[(size_t)row * PE + e] *= gelu_tanh_(s);
    }
}
DEV void st_peer_out_naive(const Params& p, int layer, bool lat_only, long gtid, long gsz) {
    const long nrows = lat_only ? NLAT : NTOK;
    for (long i = gtid; i < nrows * DM; i += gsz) {
        const int col = (int)(i % DM); const int r = (int)(i / DM); const int row = lat_only ? lat_row(r) : r;
        const int* idx = p.IDX + (size_t)row * PE; const float* act = p.GATE + (size_t)row * PE;
        float acc = 0.f;
        for (int e = 0; e < PE; ++e) acc += act[e] * bf2f(p.VB[(size_t)idx[e] * DM + col]);
        float* xr = resid_out(p, row); xr[col] += mod_row(p, layer, row)[5 * DM + col] * acc;
    }
}
DEV void st_final_naive(const Params& p, long gtid, long gsz) {
    for (long i = gtid; i < NLAT; i += gsz) {
        float* xr = p.out + (size_t)i * DM; float ss = 0.f;
        for (int k = 0; k < DM; ++k) ss += xr[k] * xr[k];
        const float rs = 1.0f / sqrtf(ss * (1.0f / DM) + EPS);
        for (int k = 0; k < DM; ++k) xr[k] = xr[k] * rs * p.final_norm[k];
    }
}

struct WsMap { size_t mod, rope, wt, kb, ctxr, h, pp, y, od, q, candv, candi, ub, vb, idx, gate, total; };
inline size_t al256(size_t x) { return (x + 255) & ~(size_t)255; }
inline WsMap ws_map() {
    WsMap m; size_t o = 0;
    m.mod = o; o = al256(o + (size_t)DEPTH * 17 * NMODW * 4);
    m.rope = o; o = al256(o + 2048 * 4);
    m.wt = o; o = al256(o + (size_t)DEPTH * WTL * 2);
    m.kb = o; o = al256(o + (size_t)DEPTH * 2 * NKEYS * 128 * 2);
    m.ctxr = o; o = al256(o + (size_t)BATCH * CTXL * DM * 4);
    m.h = o; o = al256(o + (size_t)NTOK * DM * 2);
    m.pp = o; o = al256(o + (size_t)NTOK * INW * 2);
    m.y = o; o = al256(o + (size_t)NTOK * 512 * 2);
    m.od = o; o = al256(o + (size_t)2 * NTOK * 256 * 4);
    m.total = o;
    m.q = m.pp; m.candv = al256(m.q + (size_t)NTOK * PQW * 2); m.candi = al256(m.candv + (size_t)NTOK * 256 * 4);
    m.ub = m.y; m.vb = al256(m.ub + (size_t)NEXP * DM * 2); m.idx = al256(m.vb + (size_t)NEXP * DM * 2); m.gate = al256(m.idx + (size_t)NTOK * PE * 4);
    return m;
}
inline Params make_params(void* const* d_in, void* d_out, void* d_ws) {
    Params p; memset(&p, 0, sizeof(p));
    const float* const* in = (const float* const*)d_in;
    p.x = in[0]; p.c = in[1]; p.ctx = in[2]; p.c_ctx = in[3]; p.w_mod = in[4]; p.b_mod = in[5]; p.norm_mix = in[6]; p.norm_ffn = in[7]; p.w_in = in[8]; p.conv_w = in[9];
    p.attn_sink = in[10]; p.na_rpb = in[11]; p.lb_logits = in[12]; p.group_norm = in[13]; p.w_out = in[14]; p.peer_wq = in[15]; p.peer_k1 = in[16]; p.peer_k2 = in[17];
    p.peer_u = in[18]; p.peer_v = in[19]; p.final_norm = in[20];
    p.out = (float*)d_out; char* w = (char*)d_ws; const WsMap m = ws_map();
    p.MOD = (float*)(w + m.mod); p.ROPE = (float*)(w + m.rope); p.WT = (bf16_t*)(w + m.wt); p.KB = (bf16_t*)(w + m.kb); p.CTXR = (float*)(w + m.ctxr);
    p.H = (bf16_t*)(w + m.h); p.P = (bf16_t*)(w + m.pp); p.Y = (bf16_t*)(w + m.y); p.OD = (float*)(w + m.od);
    p.Q = (bf16_t*)(w + m.q); p.CANDV = (float*)(w + m.candv); p.CANDI = (int*)(w + m.candi);
    p.UB = (bf16_t*)(w + m.ub); p.VB = (bf16_t*)(w + m.vb); p.IDX = (int*)(w + m.idx); p.GATE = (float*)(w + m.gate);
    return p;
}

#ifndef HOST_EMU
typedef short bf16x8 __attribute__((ext_vector_type(8)));
typedef float f32x4 __attribute__((ext_vector_type(4)));
typedef unsigned u32x4 __attribute__((ext_vector_type(4)));

DEV int gemm_m0(bool lat_only, int tm) { if (!lat_only) return tm * 128; const int per = SEQ / 128; return (tm / per) * TPB + CTXL + (tm % per) * 128; }
__device__ void gemm_tile_mfma(const Params& p, int layer, int mode, int m0, int n0, const bf16_t* Bt, char* smem) {
    const int tid = threadIdx.x, lane = tid & 63, wave = tid >> 6, wr = wave >> 1, wc = wave & 1, c = lane & 15, g = lane >> 4;
    const bf16_t* A = p.H + (size_t)m0 * DM; const bf16_t* B = Bt + (size_t)n0 * DM;
    f32x4 acc[4][4];
#pragma unroll
    for (int i = 0; i < 4; ++i)
#pragma unroll
        for (int j = 0; j < 4; ++j) acc[i][j] = (f32x4){0.f, 0.f, 0.f, 0.f};
    u32x4 ra[4], rb[4];
#pragma unroll
    for (int i = 0; i < 4; ++i) { const int q = tid + 256 * i, row = q >> 3, ch = q & 7; ra[i] = *(const u32x4*)(A + (size_t)row * DM + ch * 8); rb[i] = *(const u32x4*)(B + (size_t)row * DM + ch * 8); }
    constexpr int NK = DM / 64;
    for (int kt = 0; kt < NK; ++kt) {
        char* sa = smem + (kt & 1) * 32768; char* sb = sa + 16384;
#pragma unroll
        for (int i = 0; i < 4; ++i) { const int q = tid + 256 * i, row = q >> 3, ch = q & 7; const int off = row * 128 + ((ch ^ (row & 7)) << 4); *(u32x4*)(sa + off) = ra[i]; *(u32x4*)(sb + off) = rb[i]; }
        __syncthreads();
        if (kt + 1 < NK) {
#pragma unroll
            for (int i = 0; i < 4; ++i) { const int q = tid + 256 * i, row = q >> 3, ch = q & 7; ra[i] = *(const u32x4*)(A + (size_t)row * DM + (kt + 1) * 64 + ch * 8); rb[i] = *(const u32x4*)(B + (size_t)row * DM + (kt + 1) * 64 + ch * 8); }
        }
#pragma unroll
        for (int kk = 0; kk < 2; ++kk) {
            bf16x8 fa[4], fb[4];
#pragma unroll
            for (int i = 0; i < 4; ++i) { const int row = wr * 64 + i * 16 + c; fa[i] = *(const bf16x8*)(sa + row * 128 + (((kk * 4 + g) ^ (row & 7)) << 4)); }
#pragma unroll
            for (int j = 0; j < 4; ++j) { const int row = wc * 64 + j * 16 + c; fb[j] = *(const bf16x8*)(sb + row * 128 + (((kk * 4 + g) ^ (row & 7)) << 4)); }
#pragma unroll
            for (int i = 0; i < 4; ++i)
#pragma unroll
                for (int j = 0; j < 4; ++j) acc[i][j] = __builtin_amdgcn_mfma_f32_16x16x32_bf16(fb[j], fa[i], acc[i][j], 0, 0, 0);
        }
    }
#pragma unroll
    for (int i = 0; i < 4; ++i)
#pragma unroll
        for (int j = 0; j < 4; ++j)
#pragma unroll
            for (int r = 0; r < 4; ++r) gemm_epi(p, layer, mode, m0 + wr * 64 + i * 16 + c, n0 + wc * 64 + j * 16 + 4 * g + r, acc[i][j][r]);
    __syncthreads();
}
__device__ void st_gemm_mfma(const Params& p, int layer, int mode, bool lat_only, char* smem, int bid, int nb) {
    const bf16_t* Bt; int N; gemm_cfg(p, layer, mode, Bt, N);
    const int ntm = (lat_only ? NLAT : NTOK) / 128, ntn = N / 128;
    for (int t = bid; t < ntm * ntn; t += nb) { const int tn = t % ntn, tm = t / ntn; gemm_tile_mfma(p, layer, mode, gemm_m0(lat_only, tm), tn * 128, Bt, smem); }
}

#define GT ((long)blockIdx.x * blockDim.x + threadIdx.x)
#define GS ((long)gridDim.x * blockDim.x)
__global__ void __launch_bounds__(256) k_prep(Params p) { st_mod(p, GT, GS); st_wt(p, GT, GS); }
__global__ void __launch_bounds__(256) k_uvconv(Params p, int layer) { st_uvconv(p, layer, GT, GS); }
__global__ void __launch_bounds__(256) k_norm(Params p, int layer, int which, int lat_only) { st_norm_naive(p, layer, which, lat_only != 0, GT, GS); }
__global__ void __launch_bounds__(256) k_gemm(Params p, int layer, int mode, int lat_only) { __shared__ __attribute__((aligned(16))) char smem[65536]; st_gemm_mfma(p, layer, mode, lat_only != 0, smem, blockIdx.x, gridDim.x); }
__global__ void __launch_bounds__(256) k_gemm_naive(Params p, int layer, int mode, int lat_only) { st_gemm_naive(p, layer, mode, lat_only != 0, GT, GS); }
__global__ void __launch_bounds__(256) k_attnA(Params p, int layer) { st_attnA_naive(p, layer, GT, GS); }
__global__ void __launch_bounds__(256) k_attnB(Params p, int layer) { st_attnB_naive(p, layer, GT, GS); }
__global__ void __launch_bounds__(256) k_attnC(Params p, int layer) { st_attnC_naive(p, layer, GT, GS); }
__global__ void __launch_bounds__(64) k_hgrn(Params p, int layer) { st_hgrn_naive(p, layer, GT, GS); }
__global__ void __launch_bounds__(256) k_merge(Params p, int layer, int lat_only) { st_merge_naive(p, layer, lat_only != 0, GT, GS); }
__global__ void __launch_bounds__(256) k_pscores(Params p, int layer, int lat_only) { st_peer_scores_naive(p, layer, lat_only != 0, GT, GS); }
__global__ void __launch_bounds__(256) k_pcombine(Params p, int lat_only) { st_peer_combine(p, lat_only != 0, GT, GS); }
__global__ void __launch_bounds__(256) k_pact(Params p, int lat_only) { st_peer_act_naive(p, lat_only != 0, GT, GS); }
__global__ void __launch_bounds__(256) k_pout(Params p, int layer, int lat_only) { st_peer_out_naive(p, layer, lat_only != 0, GT, GS); }
__global__ void __launch_bounds__(256) k_final(Params p) { st_final_naive(p, GT, GS); }

#ifndef USE_NAIVE_GEMM
#define USE_NAIVE_GEMM 0
#endif
static void launch_gemm(const Params& p, int layer, int mode, int lat, hipStream_t s) {
    if (USE_NAIVE_GEMM) k_gemm_naive<<<4096, 256, 0, s>>>(p, layer, mode, lat);
    else { const int N = mode == 0 ? INW : (mode == 1 ? DM : PQW); const int tiles = ((lat ? NLAT : NTOK) / 128) * (N / 128); k_gemm<<<tiles, 256, 0, s>>>(p, layer, mode, lat); }
}
extern "C" void kernel_launch(void* const* d_in, const int* in_sizes, int n_in, void* d_out, int out_size, void* d_ws, size_t ws_size, hipStream_t stream) {
    const Params p = make_params(d_in, d_out, d_ws);
    k_prep<<<2048, 256, 0, stream>>>(p);
    for (int l = 0; l < DEPTH; ++l) {
        const int last = (l == DEPTH - 1) ? 1 : 0;
        k_norm<<<(NTOK + 255) / 256, 256, 0, stream>>>(p, l, 0, 0);
        launch_gemm(p, l, 0, 0, stream);
        k_hgrn<<<BATCH * 4 * 2, 64, 0, stream>>>(p, l);
        k_attnA<<<BATCH * 4 * SEQ / 256, 256, 0, stream>>>(p, l);
        k_attnB<<<BATCH * 4 * SEQ / 256, 256, 0, stream>>>(p, l);
        if (!last) k_attnC<<<BATCH * 8 * CTXL / 256, 256, 0, stream>>>(p, l);
        k_merge<<<((last ? NLAT : NTOK) * 4 + 255) / 256, 256, 0, stream>>>(p, l, last);
        launch_gemm(p, l, 1, last, stream);
        k_norm<<<((last ? NLAT : NTOK) + 255) / 256, 256, 0, stream>>>(p, l, 1, last);
        k_uvconv<<<4096, 256, 0, stream>>>(p, l);
        launch_gemm(p, l, 2, last, stream);
        k_pscores<<<((last ? NLAT : NTOK) * 16 + 255) / 256, 256, 0, stream>>>(p, l, last);
        k_pcombine<<<((last ? NLAT : NTOK) * 8 + 255) / 256, 256, 0, stream>>>(p, last);
        k_pact<<<(last ? NLAT : NTOK) * PE / 256, 256, 0, stream>>>(p, last);
        k_pout<<<(last ? NLAT : NTOK) * (DM / 256), 256, 0, stream>>>(p, l, last);
    }
    k_final<<<(NLAT + 255) / 256, 256, 0, stream>>>(p);
}
#endif
```

```cpp
#ifndef HOST_EMU
#include <hip/hip_runtime.h>
#include <hip/hip_cooperative_groups.h>
#include <cstdio>
namespace cg = cooperative_groups;
#define DEV __device__ __forceinline__
#else
#include <cmath>
#include <cstring>
#include <cstdint>
#include <cstdio>
#define DEV inline
#define __global__
#define __device__
struct float4 { float x, y, z, w; };
struct ushort4 { unsigned short x, y, z, w; };
#endif
#include <cstddef>
#include <cstring>

#ifndef CFG_BATCH
#define CFG_BATCH 16
#endif
#ifndef CFG_SEQ
#define CFG_SEQ 2048
#endif
#ifndef CFG_CTX
#define CFG_CTX 256
#endif
#ifndef CFG_NKEYS
#define CFG_NKEYS 128
#endif

typedef unsigned short bf16_t;

constexpr int BATCH = CFG_BATCH, SEQ = CFG_SEQ, CTXL = CFG_CTX, DM = 1024, DEPTH = 2;
constexpr int TPB = SEQ + CTXL;
constexpr int NTOK = BATCH * TPB;
constexpr int NLAT = BATCH * SEQ;
constexpr int INW = 3328, NMODW = 6144, GRIDW = 64, ROWS = SEQ / GRIDW;
constexpr int NKEYS = CFG_NKEYS, NEXP = NKEYS * NKEYS, PHEADS = 8, PQW = 2048, PTOPK = 16, PE = PHEADS * PTOPK;
constexpr int WTL = (INW + DM + PQW) * DM;
constexpr int C_AQ = 0, C_AK = 256, C_AV = 384, C_BQ = 512, C_BK = 768, C_BV = 1024, C_CX = 1280, C_CB = 1536, C_CC = 1792,
              C_DQ = 2048, C_DZF = 2304, C_DZB = 2560, C_DI = 2816, C_DG = 3072;
constexpr float EPS = 1e-6f, MASKV = -1e30f;

struct Params {
    const float *x, *c, *ctx, *c_ctx, *w_mod, *b_mod, *norm_mix, *norm_ffn, *w_in, *conv_w, *attn_sink, *na_rpb, *lb_logits,
                *group_norm, *w_out, *peer_wq, *peer_k1, *peer_k2, *peer_u, *peer_v, *final_norm;
    float* out;
    float* MOD;
    float* ROPE;
    int* TICKET;
    bf16_t* WT;
    bf16_t* KB;
    float* CTXR;
    bf16_t* H;
    bf16_t* P;
    bf16_t* Y;
    float* OD;
    bf16_t* ODH;
    bf16_t* RB;
    bf16_t* Q;
    float* CANDV;
    int* CANDI;
    bf16_t* UB;
    bf16_t* VB;
    unsigned char* U8;
    unsigned char* V8;
    unsigned* BAR;
    int* IDX;
    float* GATE;
};

DEV float u2f(unsigned u) { float f; memcpy(&f, &u, 4); return f; }
DEV unsigned f2u(float f) { unsigned u; memcpy(&u, &f, 4); return u; }
DEV bf16_t f2bf(float f) { unsigned u = f2u(f); u += 0x7fffu + ((u >> 16) & 1u); return (bf16_t)(u >> 16); }
DEV float bf2f(bf16_t h) { return u2f(((unsigned)h) << 16); }
DEV float sigmoidf_(float x) { return 1.0f / (1.0f + expf(-x)); }
DEV float siluf_(float x) { return x * sigmoidf_(x); }
DEV float gelu_tanh_(float x) { const float u = 0.7978845608028654f * (x + 0.044715f * x * x * x); const float t = 1.0f - 2.0f / (1.0f + expf(2.0f * u)); return 0.5f * x * (1.0f + t); }
DEV int clampi(int v, int lo, int hi) { return v < lo ? lo : (v > hi ? hi : v); }

DEV const float* resid_in(const Params& p, int layer, int row) {
    const int b = row / TPB, pp = row % TPB;
    if (pp < CTXL) return (layer == 0 ? p.ctx : p.CTXR) + ((size_t)b * CTXL + pp) * DM;
    return (layer == 0 ? p.x : p.out) + ((size_t)b * SEQ + (pp - CTXL)) * DM;
}
DEV float* resid_out(const Params& p, int row) {
    const int b = row / TPB, pp = row % TPB;
    if (pp < CTXL) return p.CTXR + ((size_t)b * CTXL + pp) * DM;
    return p.out + ((size_t)b * SEQ + (pp - CTXL)) * DM;
}
DEV const float* mod_row(const Params& p, int layer, int row) {
    const int b = row / TPB, pp = row % TPB;
    return p.MOD + ((size_t)layer * 17 + (pp < CTXL ? 16 : b)) * NMODW;
}
DEV int lat_row(int i) { return (i / SEQ) * TPB + CTXL + (i % SEQ); }

DEV void st_mod(const Params& p, long gtid, long gsz) {
    for (long i = gtid; i < (long)DEPTH * 17 * NMODW; i += gsz) {
        const int n = (int)(i % NMODW), r = (int)((i / NMODW) % 17), l = (int)(i / ((long)NMODW * 17));
        const float* cv = (r < 16) ? (p.c + (size_t)(r < BATCH ? r : 0) * DM) : p.c_ctx;
        const float* w = p.w_mod + (size_t)l * DM * NMODW + n;
        float acc = 0.f;
        for (int k = 0; k < DM; ++k) acc += siluf_(cv[k]) * w[(size_t)k * NMODW];
        p.MOD[i] = acc + p.b_mod[(size_t)l * NMODW + n];
    }
}
DEV void st_wt(const Params& p, long gtid, long gsz) {
    for (long i = gtid; i < (long)DEPTH * WTL; i += gsz) {
        const int l = (int)(i / WTL); const long e = i % WTL; const int n = (int)(e / DM), k = (int)(e % DM);
        float v;
        if (n < INW) v = p.w_in[((size_t)l * DM + k) * INW + n];
        else if (n < INW + DM) v = p.w_out[((size_t)l * DM + k) * DM + (n - INW)];
        else v = p.peer_wq[((size_t)l * DM + k) * PQW + (n - INW - DM)];
        p.WT[i] = f2bf(v);
    }
    for (long i = gtid; i < (long)DEPTH * 2 * NKEYS * 128; i += gsz) {
        const int l = (int)(i / (2 * NKEYS * 128)); const int e = (int)(i % (2 * NKEYS * 128)); const int hf = e / (NKEYS * 128), r = e % (NKEYS * 128);
        p.KB[i] = f2bf((hf ? p.peer_k2 : p.peer_k1)[(size_t)l * NKEYS * 128 + r]);
    }
    for (long i = gtid; i < 64 * 16; i += gsz) {
        const int pos = (int)(i / 16), f = (int)(i % 16);
        const float inv = powf(10000.0f, -((float)(2 * f)) / 32.0f);
        const float ang = (float)pos * inv;
        p.ROPE[i] = cosf(ang); p.ROPE[1024 + i] = sinf(ang);
    }
}
DEV void st_uvconv(const Params& p, int layer, long gtid, long gsz) {
    const float* u = p.peer_u + (size_t)layer * NEXP * DM; const float* v = p.peer_v + (size_t)layer * NEXP * DM;
    for (long i = gtid; i < (long)NEXP * DM / 4; i += gsz) {
        const float4 a = ((const float4*)u)[i], b = ((const float4*)v)[i];
        ushort4 ua, ub; ua.x = f2bf(a.x); ua.y = f2bf(a.y); ua.z = f2bf(a.z); ua.w = f2bf(a.w); ub.x = f2bf(b.x); ub.y = f2bf(b.y); ub.z = f2bf(b.z); ub.w = f2bf(b.w);
        ((ushort4*)p.UB)[i] = ua; ((ushort4*)p.VB)[i] = ub;
    }
}

DEV void st_norm_naive(const Params& p, int layer, int which, bool lat_only, long gtid, long gsz) {
    const int nrows = lat_only ? NLAT : NTOK;
    for (long i = gtid; i < nrows; i += gsz) {
        const int row = lat_only ? lat_row((int)i) : (int)i;
        const float* xr = resid_in(p, (which == 0) ? layer : 1, row);
        const float* m = mod_row(p, layer, row);
        const float* g = (which ? p.norm_ffn : p.norm_mix) + (size_t)layer * DM;
        const float* sh = m + (which ? 3 : 0) * DM; const float* sc = m + (which ? 4 : 1) * DM;
        float ss = 0.f;
        for (int k = 0; k < DM; ++k) ss += xr[k] * xr[k];
        const float rs = 1.0f / sqrtf(ss * (1.0f / DM) + EPS);
        bf16_t* h = p.H + (size_t)row * DM;
        for (int k = 0; k < DM; ++k) h[k] = f2bf(xr[k] * rs * g[k] * (1.0f + sc[k]) + sh[k]);
    }
}

DEV void gemm_epi(const Params& p, int layer, int mode, int row, int col, float acc) {
    if (mode == 0) p.P[(size_t)row * INW + col] = f2bf(acc);
    else if (mode == 2) p.Q[(size_t)row * PQW + col] = f2bf(acc);
    else { const float g1 = mod_row(p, layer, row)[2 * DM + col]; resid_out(p, row)[col] = resid_in(p, layer, row)[col] + g1 * acc; }
}
DEV void gemm_cfg(const Params& p, int layer, int mode, const bf16_t*& Bt, int& N) {
    const bf16_t* w = p.WT + (size_t)layer * WTL;
    if (mode == 0) { Bt = w; N = INW; } else if (mode == 1) { Bt = w + (size_t)INW * DM; N = DM; } else { Bt = w + (size_t)(INW + DM) * DM; N = PQW; }
}
DEV void st_gemm_naive(const Params& p, int layer, int mode, bool lat_only, long gtid, long gsz) {
    const bf16_t* Bt; int N; gemm_cfg(p, layer, mode, Bt, N);
    const long nrows = lat_only ? NLAT : NTOK;
    for (long i = gtid; i < nrows * N; i += gsz) {
        const int col = (int)(i % N); const int r = (int)(i / N); const int row = lat_only ? lat_row(r) : r;
        const bf16_t* a = p.H + (size_t)row * DM; const bf16_t* b = Bt + (size_t)col * DM;
        float acc = 0.f;
        for (int k = 0; k < DM; ++k) acc += bf2f(a[k]) * bf2f(b[k]);
        gemm_epi(p, layer, mode, row, col, acc);
    }
}

DEV void rope_load(const Params& p, const bf16_t* src, int t, float* dst) {
    const float* cs = p.ROPE; const float* sn = p.ROPE + 1024; const int r = t / GRIDW, c = t % GRIDW;
#pragma unroll
    for (int i = 0; i < 16; ++i) {
        const float x1 = bf2f(src[i]), x2 = bf2f(src[16 + i]); const float cr = cs[r * 16 + i], sr = sn[r * 16 + i];
        dst[i] = x1 * cr - x2 * sr; dst[16 + i] = x1 * sr + x2 * cr;
        const float y1 = bf2f(src[32 + i]), y2 = bf2f(src[48 + i]); const float cc = cs[c * 16 + i], sc = sn[c * 16 + i];
        dst[32 + i] = y1 * cc - y2 * sc; dst[48 + i] = y1 * sc + y2 * cc;
    }
}
DEV float rope_dot(const Params& p, const float* q, const bf16_t* src, int t) {
    const float* cs = p.ROPE; const float* sn = p.ROPE + 1024; const int r = t / GRIDW, c = t % GRIDW; float acc = 0.f;
#pragma unroll
    for (int i = 0; i < 16; ++i) {
        const float x1 = bf2f(src[i]), x2 = bf2f(src[16 + i]); const float cr = cs[r * 16 + i], sr = sn[r * 16 + i];
        acc += q[i] * (x1 * cr - x2 * sr) + q[16 + i] * (x1 * sr + x2 * cr);
        const float y1 = bf2f(src[32 + i]), y2 = bf2f(src[48 + i]); const float cc = cs[c * 16 + i], sc = sn[c * 16 + i];
        acc += q[32 + i] * (y1 * cc - y2 * sc) + q[48 + i] * (y1 * sc + y2 * cc);
    }
    return acc;
}
struct OnlineSm { float m, l; float o[64]; };
DEV void osm_init(OnlineSm& s) { s.m = MASKV; s.l = 0.f;
#pragma unroll
    for (int d = 0; d < 64; ++d) s.o[d] = 0.f; }
DEV void osm_add(OnlineSm& s, float sc, const bf16_t* vrow) {
    const float mn = sc > s.m ? sc : s.m; const float a = expf(s.m - mn), pe = expf(sc - mn);
    s.l = s.l * a + pe; s.m = mn;
#pragma unroll
    for (int d = 0; d < 64; ++d) s.o[d] = s.o[d] * a + pe * bf2f(vrow[d]);
}
DEV void osm_sink(OnlineSm& s, float sk) { const float mn = sk > s.m ? sk : s.m; const float a = expf(s.m - mn);
    s.l = s.l * a + expf(sk - mn); s.m = mn;
#pragma unroll
    for (int d = 0; d < 64; ++d) s.o[d] *= a; }
DEV void osm_store(const OnlineSm& s, bf16_t* dst) { const float inv = 1.0f / s.l;
#pragma unroll
    for (int d = 0; d < 64; ++d) dst[d] = f2bf(s.o[d] * inv); }

DEV void st_attnA_naive(const Params& p, int layer, long gtid, long gsz) {
    for (long i = gtid; i < (long)BATCH * 4 * SEQ; i += gsz) {
        const int t = (int)(i % SEQ), h = (int)((i / SEQ) % 4), b = (int)(i / ((long)SEQ * 4)); const int hk = h >> 1;
        const bf16_t* Pb = p.P + (size_t)b * TPB * INW;
        float q[64]; rope_load(p, Pb + (size_t)(CTXL + t) * INW + C_AQ + h * 64, t, q);
        OnlineSm s; osm_init(s);
        const int k0 = t - 128 < 0 ? 0 : t - 128, k1 = t + 128 > SEQ - 1 ? SEQ - 1 : t + 128;
        for (int kp = k0; kp <= k1; ++kp) {
            const bf16_t* kr = Pb + (size_t)(CTXL + kp) * INW;
            const float sc = rope_dot(p, q, kr + C_AK + hk * 64, kp);
            osm_add(s, sc * 0.125f, kr + C_AV + hk * 64);
        }
        for (int kc = 0; kc < CTXL; ++kc) {
            const bf16_t* kr = Pb + (size_t)kc * INW; float sc = 0.f;
#pragma unroll
            for (int d = 0; d < 64; ++d) sc += q[d] * bf2f(kr[C_AK + hk * 64 + d]);
            osm_add(s, sc * 0.125f, kr + C_AV + hk * 64);
        }
        osm_sink(s, p.attn_sink[layer * 4 + h]);
        osm_store(s, p.Y + ((size_t)b * TPB + CTXL + t) * 512 + h * 64);
    }
}
DEV void st_attnB_naive(const Params& p, int layer, long gtid, long gsz) {
    for (long i = gtid; i < (long)BATCH * 4 * SEQ; i += gsz) {
        const int t = (int)(i % SEQ), h = (int)((i / SEQ) % 4), b = (int)(i / ((long)SEQ * 4));
        const bf16_t* Pb = p.P + (size_t)b * TPB * INW;
        const int r = t / GRIDW, qc = t % GRIDW; const int rs = clampi(r - 4, 0, ROWS - 8), w0 = clampi(qc - 8, 0, GRIDW - 16);
        const float* rpb = p.na_rpb + ((size_t)layer * 4 + h) * 15 * 31;
        float q[64];
#pragma unroll
        for (int d = 0; d < 64; ++d) q[d] = bf2f(Pb[(size_t)(CTXL + t) * INW + C_BQ + h * 64 + d]);
        OnlineSm s; osm_init(s);
        for (int kr_ = rs; kr_ < rs + 8; ++kr_)
            for (int kc = w0; kc < w0 + 16; ++kc) {
                const bf16_t* kr = Pb + (size_t)(CTXL + kr_ * GRIDW + kc) * INW; float sc = 0.f;
#pragma unroll
                for (int d = 0; d < 64; ++d) sc += q[d] * bf2f(kr[C_BK + h * 64 + d]);
                osm_add(s, sc * 0.125f + rpb[(kr_ - r + 7) * 31 + (kc - qc + 15)], kr + C_BV + h * 64);
            }
        for (int kc = 0; kc < CTXL; ++kc) {
            const bf16_t* kr = Pb + (size_t)kc * INW; float sc = 0.f;
#pragma unroll
            for (int d = 0; d < 64; ++d) sc += q[d] * bf2f(kr[C_BK + h * 64 + d]);
            osm_add(s, sc * 0.125f, kr + C_BV + h * 64);
        }
        osm_store(s, p.Y + ((size_t)b * TPB + CTXL + t) * 512 + 256 + h * 64);
    }
}
DEV void st_attnC_naive(const Params& p, int layer, long gtid, long gsz) {
    for (long i = gtid; i < (long)BATCH * 2 * 4 * CTXL; i += gsz) {
        const int tq = (int)(i % CTXL), h = (int)((i / CTXL) % 4), wh = (int)((i / (CTXL * 4)) % 2), b = (int)(i / ((long)CTXL * 8));
        const bf16_t* Pb = p.P + (size_t)b * TPB * INW;
        const int qcol = wh ? C_BQ + h * 64 : C_AQ + h * 64, kcol = wh ? C_BK + h * 64 : C_AK + (h >> 1) * 64, vcol = wh ? C_BV + h * 64 : C_AV + (h >> 1) * 64;
        float q[64];
#pragma unroll
        for (int d = 0; d < 64; ++d) q[d] = bf2f(Pb[(size_t)tq * INW + qcol + d]);
        OnlineSm s; osm_init(s);
        for (int kc = 0; kc < CTXL; ++kc) {
            const bf16_t* kr = Pb + (size_t)kc * INW; float sc = 0.f;
#pragma unroll
            for (int d = 0; d < 64; ++d) sc += q[d] * bf2f(kr[kcol + d]);
            osm_add(s, sc * 0.125f, kr + vcol);
        }
        if (!wh) osm_sink(s, p.attn_sink[layer * 4 + h]);
        osm_store(s, p.Y + ((size_t)b * TPB + tq) * 512 + wh * 256 + h * 64);
    }
}
DEV float hgrn_lb(const Params& p, int layer, int ch) { if (layer == 0) return 0.f; return sigmoidf_(p.lb_logits[256 + ch] - p.lb_logits[ch]); }
DEV void st_hgrn_naive(const Params& p, int layer, long gtid, long gsz) {
    for (long i = gtid; i < (long)BATCH * 4 * 2 * 64; i += gsz) {
        const int v = (int)(i % 64), dir = (int)((i / 64) % 2), h = (int)((i / 128) % 4), b = (int)(i / 512);
        const bf16_t* Pb = p.P + (size_t)b * TPB * INW; const int zc = (dir ? C_DZB : C_DZF) + h * 64;
        float S[64], lb[64];
#pragma unroll
        for (int d = 0; d < 64; ++d) { S[d] = 0.f; lb[d] = hgrn_lb(p, layer, h * 64 + d); }
        float* od = p.OD + ((size_t)dir * NTOK + (size_t)b * TPB) * 256 + h * 64 + v;
        for (int st = 0; st < TPB; ++st) {
            int pp;
            if (st < CTXL) pp = dir ? CTXL - 1 - st : st; else { const int t = st - CTXL; pp = CTXL + (dir ? SEQ - 1 - t : t); }
            const bf16_t* pr = Pb + (size_t)pp * INW; const float vv = bf2f(pr[C_DI + h * 64 + v]); float o = 0.f;
#pragma unroll
            for (int d = 0; d < 64; ++d) {
                const float z = bf2f(pr[zc + d]); const float sg = sigmoidf_(z);
                const float f = lb[d] + (1.0f - lb[d]) * sg, k = (1.0f - lb[d]) * (1.0f - sg);
                S[d] = f * S[d] + k * vv; o += bf2f(pr[C_DQ + h * 64 + d]) * S[d];
            }
            od[(size_t)pp * 256] = o;
        }
    }
}
DEV float mixC_val(const Params& p, int layer, int row, int ch) {
    const int pp = row % TPB; const bool isctx = pp < CTXL; const int lo = isctx ? 0 : CTXL, hi = isctx ? CTXL - 1 : TPB - 1;
    const bf16_t* pr = p.P + (size_t)row * INW; const float* w = p.conv_w + (size_t)layer * 3 * 256;
    float acc = 0.f;
#pragma unroll
    for (int j = 0; j < 3; ++j) { const int q = pp + j - 1; if (q >= lo && q <= hi) { const bf16_t* nr = pr + (ptrdiff_t)(j - 1) * INW; acc += w[j * 256 + ch] * bf2f(nr[C_CC + ch]) * bf2f(nr[C_CX + ch]); } }
    return bf2f(pr[C_CB + ch]) * acc;
}
DEV float mixD_val(const Params& p, int row, int ch) {
    const float o = p.OD[(size_t)row * 256 + ch] + p.OD[((size_t)NTOK + row) * 256 + ch];
    return o * siluf_(bf2f(p.P[(size_t)row * INW + C_DG + ch]));
}
DEV void st_merge_naive(const Params& p, int layer, bool lat_only, long gtid, long gsz) {
    const long nrows = lat_only ? NLAT : NTOK;
    for (long i = gtid; i < nrows * 4; i += gsz) {
        const int g = (int)(i % 4); const int r = (int)(i / 4); const int row = lat_only ? lat_row(r) : r;
        float ss = 0.f;
        for (int ch = 0; ch < 256; ++ch) { const float y = g < 2 ? bf2f(p.Y[(size_t)row * 512 + g * 256 + ch]) : (g == 2 ? mixC_val(p, layer, row, ch) : mixD_val(p, row, ch)); ss += y * y; }
        const float rs = 1.0f / sqrtf(ss * (1.0f / 256.0f) + EPS); const float* gn = p.group_norm + (size_t)layer * DM + g * 256;
        for (int ch = 0; ch < 256; ++ch) { const float y = g < 2 ? bf2f(p.Y[(size_t)row * 512 + g * 256 + ch]) : (g == 2 ? mixC_val(p, layer, row, ch) : mixD_val(p, row, ch));
            p.H[(size_t)row * DM + g * 256 + ch] = f2bf(y * rs * gn[ch]); }
    }
}

#define TOPK_INS(V, I, xv, xi) { float x_ = (xv); int j_ = (xi); _Pragma("unroll") for (int q_ = 0; q_ < 16; ++q_) { if (x_ > V[q_]) { const float tv_ = V[q_]; const int ti_ = I[q_]; V[q_] = x_; I[q_] = j_; x_ = tv_; j_ = ti_; } } }
DEV void st_peer_scores_naive(const Params& p, int layer, bool lat_only, long gtid, long gsz) {
    const long nrows = lat_only ? NLAT : NTOK;
    for (long i = gtid; i < nrows * 16; i += gsz) {
        const int hh = (int)(i % 16); const int r = (int)(i / 16); const int row = lat_only ? lat_row(r) : r; const int hf = hh & 1;
        const bf16_t* q = p.Q + (size_t)row * PQW + hh * 128; const bf16_t* kb = p.KB + ((size_t)layer * 2 + hf) * NKEYS * 128;
        float V[16]; int I[16];
#pragma unroll
        for (int j = 0; j < 16; ++j) { V[j] = -3.0e38f; I[j] = 0; }
        for (int k = 0; k < NKEYS; ++k) { float s = 0.f; for (int d = 0; d < 128; ++d) s += bf2f(q[d]) * bf2f(kb[(size_t)k * 128 + d]); TOPK_INS(V, I, s, k); }
#pragma unroll
        for (int j = 0; j < 16; ++j) { p.CANDV[((size_t)row * 16 + hh) * 16 + j] = V[j]; p.CANDI[((size_t)row * 16 + hh) * 16 + j] = I[j]; }
    }
}
template <int A, int B> struct CombKey {
    static DEV void run(float (&V)[16], const float (&a1)[16], const float (&a2)[16]) {
        if constexpr ((A + 1) * (B + 1) <= 16) {
            float x = u2f((f2u(a1[A] + a2[B]) & ~0xFFu) | (unsigned)(A * 16 + B));
#pragma unroll
            for (int q = 0; q < 16; ++q) { const float hi = fmaxf(V[q], x), lo = fminf(V[q], x); V[q] = hi; x = lo; }
            CombKey<A, B + 1>::run(V, a1, a2); }
        else if constexpr (A < 15) CombKey<A + 1, 0>::run(V, a1, a2);
    }
};
template <int A, int B> struct CombStep {
    static DEV void run(float (&V)[16], int (&I)[16], const float (&a1)[16], const float (&a2)[16], const int (&b1)[16], const int (&b2)[16]) {
        if constexpr ((A + 1) * (B + 1) <= 16) { TOPK_INS(V, I, a1[A] + a2[B], b1[A] * NKEYS + b2[B]); CombStep<A, B + 1>::run(V, I, a1, a2, b1, b2); }
        else if constexpr (A < 15) CombStep<A + 1, 0>::run(V, I, a1, a2, b1, b2);
    }
};
DEV void st_peer_combine(const Params& p, bool lat_only, long gtid, long gsz) {
    const long nrows = lat_only ? NLAT : NTOK;
    for (long i = gtid; i < nrows * 8; i += gsz) {
        const int h = (int)(i % 8); const int r = (int)(i / 8); const int row = lat_only ? lat_row(r) : r;
        const float* v1 = p.CANDV + ((size_t)row * 16 + h * 2) * 16; const float* v2 = v1 + 16; const int* i1 = p.CANDI + ((size_t)row * 16 + h * 2) * 16; const int* i2 = i1 + 16;
        float a1[16], a2[16]; int b1[16], b2[16];
#pragma unroll
        for (int j = 0; j < 16; ++j) { a1[j] = v1[j]; a2[j] = v2[j]; b1[j] = i1[j]; b2[j] = i2[j]; }
        float V[16]; int I[16];
#pragma unroll
        for (int j = 0; j < 16; ++j) { V[j] = -3.0e38f; I[j] = 0; }
        CombStep<0, 0>::run(V, I, a1, a2, b1, b2);
        float sum = 0.f, e[16];
#pragma unroll
        for (int j = 0; j < 16; ++j) { e[j] = expf(V[j] - V[0]); sum += e[j]; }
        const float inv = 1.0f / sum;
#pragma unroll
        for (int j = 0; j < 16; ++j) { p.IDX[(size_t)row * PE + h * 16 + j] = I[j]; p.GATE[(size_t)row * PE + h * 16 + j] = e[j] * inv; }
    }
}
DEV void st_peer_act_naive(const Params& p, bool lat_only, long gtid, long gsz) {
    const long nrows = lat_only ? NLAT : NTOK;
    for (long i = gtid; i < nrows * PE; i += gsz) {
        const int e = (int)(i % PE); const int r = (int)(i / PE); const int row = lat_only ? lat_row(r) : r;
        const bf16_t* h = p.H + (size_t)row * DM; const bf16_t* u = p.UB + (size_t)p.IDX[(size_t)row * PE + e] * DM;
        float s = 0.f;
        for (int k = 0; k < DM; ++k) s += bf2f(h[k]) * bf2f(u[k]);
        p.GATE[(size_t)row * PE + e] *= gelu_tanh_(s);
    }
}
DEV void st_peer_out_naive(const Params& p, int layer, bool lat_only, long gtid, long gsz) {
    const long nrows = lat_only ? NLAT : NTOK;
    for (long i = gtid; i < nrows * DM; i += gsz) {
        const int col = (int)(i % DM); const int r = (int)(i / DM); const int row = lat_only ? lat_row(r) : r;
        const int* idx = p.IDX + (size_t)row * PE; const float* act = p.GATE + (size_t)row * PE;
        float acc = 0.f;
        for (int e = 0; e < PE; ++e) acc += act[e] * bf2f(p.VB[(size_t)idx[e] * DM + col]);
        float* xr = resid_out(p, row); xr[col] += mod_row(p, layer, row)[5 * DM + col] * acc;
    }
}
DEV void st_final_naive(const Params& p, long gtid, long gsz) {
    for (long i = gtid; i < NLAT; i += gsz) {
        float* xr = p.out + (size_t)i * DM; float ss = 0.f;
        for (int k = 0; k < DM; ++k) ss += xr[k] * xr[k];
        const float rs = 1.0f / sqrtf(ss * (1.0f / DM) + EPS);
        for (int k = 0; k < DM; ++k) xr[k] = xr[k] * rs * p.final_norm[k];
    }
}

struct WsMap { size_t u8, mod, rope, ticket, wt, kb, ctxr, h, pp, y, od, rb, q, candv, candi, ub, vb, idx, gate, total; };
inline size_t al256(size_t x) { return (x + 255) & ~(size_t)255; }
inline WsMap ws_map() {
    WsMap m; size_t o = 0;
    m.mod = o; o = al256(o + (size_t)DEPTH * 17 * NMODW * 4);
    m.rope = o; o = al256(o + 2048 * 4);
    m.ticket = o; o = al256(o + 256 + 3456 * 4);
    m.wt = o; o = al256(o + (size_t)DEPTH * WTL * 2);
    m.kb = o; o = al256(o + (size_t)DEPTH * 2 * NKEYS * 128 * 2);
#ifdef HOST_EMU
    m.ctxr = o; o = al256(o + (size_t)BATCH * CTXL * DM * 4);
#else
    m.ctxr = o;
#endif
    m.h = o; o = al256(o + (size_t)NTOK * DM * 2);
    m.pp = o; o = al256(o + (size_t)NTOK * INW * 2);
    m.y = o; o = al256(o + (size_t)NTOK * 512 * 2);
#ifdef HOST_EMU
    m.od = o; o = al256(o + (size_t)2 * NTOK * 256 * 4);
    m.u8 = o; o = al256(o + (size_t)2 * NEXP * DM);
#else
    m.od = o; o = al256(o + (size_t)2 * NTOK * 256 * 2);
    m.u8 = o; o = al256(o + (size_t)NEXP * DM);
#endif
    m.rb = o; o = al256(o + (size_t)NTOK * DM * 2);
    m.total = o;
    m.q = m.pp; m.candv = al256(m.q + (size_t)NTOK * PQW * 2); m.candi = al256(m.candv + (size_t)NTOK * 256 * 4);
    m.ub = m.y; m.vb = al256(m.ub + (size_t)NEXP * DM * 2); m.idx = al256(m.vb + (size_t)NEXP * DM * 2); m.gate = al256(m.idx + (size_t)NTOK * PE * 4);
    return m;
}
inline Params make_params(void* const* d_in, void* d_out, void* d_ws) {
    Params p; memset(&p, 0, sizeof(p));
    const float* const* in = (const float* const*)d_in;
    p.x = in[0]; p.c = in[1]; p.ctx = in[2]; p.c_ctx = in[3]; p.w_mod = in[4]; p.b_mod = in[5]; p.norm_mix = in[6]; p.norm_ffn = in[7]; p.w_in = in[8]; p.conv_w = in[9];
    p.attn_sink = in[10]; p.na_rpb = in[11]; p.lb_logits = in[12]; p.group_norm = in[13]; p.w_out = in[14]; p.peer_wq = in[15]; p.peer_k1 = in[16]; p.peer_k2 = in[17];
    p.peer_u = in[18]; p.peer_v = in[19]; p.final_norm = in[20];
    p.out = (float*)d_out; char* w = (char*)d_ws; const WsMap m = ws_map();
    p.MOD = (float*)(w + m.mod); p.ROPE = (float*)(w + m.rope); p.TICKET = (int*)(w + m.ticket); p.WT = (bf16_t*)(w + m.wt); p.KB = (bf16_t*)(w + m.kb); p.CTXR = (float*)(w + m.ctxr);
    p.H = (bf16_t*)(w + m.h); p.P = (bf16_t*)(w + m.pp); p.Y = (bf16_t*)(w + m.y); p.OD = (float*)(w + m.od); p.ODH = (bf16_t*)(w + m.od); p.RB = (bf16_t*)(w + m.rb);
    p.Q = (bf16_t*)(w + m.q); p.CANDV = (float*)(w + m.candv); p.CANDI = (int*)(w + m.candi);
    p.UB = (bf16_t*)(w + m.ub); p.U8 = (unsigned char*)(w + m.u8); p.V8 = p.U8 + (size_t)NEXP * DM / 2; p.BAR = (unsigned*)(w + m.ticket + 256); p.VB = (bf16_t*)(w + m.vb); p.IDX = (int*)(w + m.idx); p.GATE = (float*)(w + m.gate);
    return p;
}

#ifndef HOST_EMU
typedef short bf16x8 __attribute__((ext_vector_type(8)));
typedef float f32x4 __attribute__((ext_vector_type(4)));
typedef unsigned u32x4 __attribute__((ext_vector_type(4)));
#define LAS __attribute__((address_space(3)))
DEV int otid() { int t = threadIdx.x; asm volatile("" : "+v"(t)); return t; }
#define GT ((long)blockIdx.x * blockDim.x + otid())
#define GS ((long)gridDim.x * blockDim.x)
typedef float f32x2 __attribute__((ext_vector_type(2)));
template <int CTRL> DEV float dppf(float x) { return __builtin_bit_cast(float, __builtin_amdgcn_update_dpp(0, __builtin_bit_cast(int, x), CTRL, 0xF, 0xF, false)); }
DEV float row16_sum(float x) { x += dppf<0x128>(x); x += dppf<0x124>(x); x += dppf<0x122>(x); x += dppf<0x121>(x); return x; }
DEV float rdlane(float x, int l) { return __builtin_bit_cast(float, __builtin_amdgcn_readlane(__builtin_bit_cast(int, x), l)); }
DEV float wave_sum(float x) { x = row16_sum(x); return (rdlane(x, 0) + rdlane(x, 16)) + (rdlane(x, 32) + rdlane(x, 48)); }
DEV float bflo(unsigned u) { return u2f(u << 16); }
DEV float bfhi(unsigned u) { return u2f(u & 0xffff0000u); }
typedef __bf16 hwbf2 __attribute__((ext_vector_type(2)));
DEV unsigned pack2bf(float a, float b) { const f32x2 v = {a, b}; return __builtin_bit_cast(unsigned, __builtin_convertvector(v, hwbf2)); }
DEV bf16_t f2bf_hw(float a) { return (bf16_t)(pack2bf(a, 0.f) & 0xffffu); }
DEV void unpack8(const u32x4& r, float* x) { x[0] = bflo(r.x); x[1] = bfhi(r.x); x[2] = bflo(r.y); x[3] = bfhi(r.y); x[4] = bflo(r.z); x[5] = bfhi(r.z); x[6] = bflo(r.w); x[7] = bfhi(r.w); }


DEV int gemm_m0(bool lat_only, int tm) { if (!lat_only) return tm * 128; const int per = SEQ / 128; return (tm / per) * TPB + CTXL + (tm % per) * 128; }
#define CE_DESC(a, b) { const float hi_ = fmaxf(a, b), lo_ = fminf(a, b); a = hi_; b = lo_; }
template <int N> DEV void bitonic_sort_desc(float (&v)[N]) {
#pragma unroll
    for (int k = 2; k <= N; k <<= 1)
#pragma unroll
        for (int j = k >> 1; j > 0; j >>= 1)
#pragma unroll
            for (int i = 0; i < N; ++i) { const int l = i ^ j; if (l > i) { if ((i & k) == 0 || k == N) { CE_DESC(v[i], v[l]); } else { CE_DESC(v[l], v[i]); } } }
}
template <int N> DEV void bitonic_merge_desc(float (&v)[N]) {
#pragma unroll
    for (int j = N >> 1; j > 0; j >>= 1)
#pragma unroll
        for (int i = 0; i < N; ++i) { const int l = i ^ j; if (l > i) { CE_DESC(v[i], v[l]); } }
}
DEV void peer_score_epilogue(const Params& p, int layer, int m0, int hh, const f32x4 (&acc)[4][4], char* smem, int tid, const u32x4 (&kreg)[8]) {
    const int lane = tid & 63, wave = tid >> 6, wr = wave >> 1, wc = wave & 1, c = lane & 15, g = lane >> 4;
    char* Qs = smem; char* Ks2 = smem + 32768;
    __syncthreads();
#pragma unroll
    for (int i = 0; i < 4; ++i)
#pragma unroll
        for (int j = 0; j < 4; ++j) { const int tok = wr * 64 + i * 16 + c, chunk = wc * 8 + j * 2 + (g >> 1);
            uint2 o; o.x = pack2bf(acc[i][j][0], acc[i][j][1]); o.y = pack2bf(acc[i][j][2], acc[i][j][3]);
            *(uint2*)(Qs + tok * 256 + ((chunk ^ (tok & 15)) << 4) + (g & 1) * 8) = o; }
    {
#pragma unroll
      for (int i = 0; i < 8; ++i) { const int q = tid + 256 * i, key = q >> 4, ch = q & 15; *(u32x4*)(Ks2 + key * 256 + ((ch ^ (key & 15)) << 4)) = kreg[i]; } }
    __syncthreads();
    f32x4 S[8][2];
#pragma unroll
    for (int kt = 0; kt < 8; ++kt) { S[kt][0] = (f32x4){0.f, 0.f, 0.f, 0.f}; S[kt][1] = (f32x4){0.f, 0.f, 0.f, 0.f}; }
#pragma unroll
    for (int kk = 0; kk < 4; ++kk) {
        bf16x8 qf[2];
#pragma unroll
        for (int tt = 0; tt < 2; ++tt) { const int tok = wave * 32 + tt * 16 + c; qf[tt] = *(const bf16x8*)(Qs + tok * 256 + (((4 * kk + g) ^ (tok & 15)) << 4)); }
#pragma unroll
        for (int kt = 0; kt < 8; ++kt) { const int key = kt * 16 + c; const bf16x8 kf = *(const bf16x8*)(Ks2 + key * 256 + (((4 * kk + g) ^ (key & 15)) << 4));
            S[kt][0] = __builtin_amdgcn_mfma_f32_16x16x32_bf16(kf, qf[0], S[kt][0], 0, 0, 0); S[kt][1] = __builtin_amdgcn_mfma_f32_16x16x32_bf16(kf, qf[1], S[kt][1], 0, 0, 0); }
    }
#pragma unroll
    for (int tt = 0; tt < 2; ++tt) {
        float A[16], B[16];
#pragma unroll
        for (int kt = 0; kt < 4; ++kt)
#pragma unroll
            for (int r = 0; r < 4; ++r) {
                A[kt * 4 + r] = u2f((f2u(S[kt][tt][r]) & ~0x7Fu) | (unsigned)(kt * 16 + 4 * g + r));
                B[kt * 4 + r] = u2f((f2u(S[kt + 4][tt][r]) & ~0x7Fu) | (unsigned)((kt + 4) * 16 + 4 * g + r)); }
        bitonic_sort_desc<16>(A); bitonic_sort_desc<16>(B);
#pragma unroll
        for (int j = 0; j < 16; ++j) A[j] = fmaxf(A[j], B[15 - j]);
        bitonic_merge_desc<16>(A);
#pragma unroll
        for (int rnd = 0; rnd < 2; ++rnd) {
#pragma unroll
            for (int j = 0; j < 16; ++j) B[j] = __shfl_xor(A[j], 16 << rnd, 64);
#pragma unroll
            for (int j = 0; j < 16; ++j) A[j] = fmaxf(A[j], B[15 - j]);
            bitonic_merge_desc<16>(A);
        }
        if (g == 0) { const int row = m0 + wave * 32 + tt * 16 + c; float* cv = p.CANDV + ((size_t)row * 16 + hh) * 16; int* ci = p.CANDI + ((size_t)row * 16 + hh) * 16;
#pragma unroll
            for (int j = 0; j < 16; j += 4) { *(float4*)(cv + j) = (float4){u2f(f2u(A[j]) & ~0x7Fu), u2f(f2u(A[j + 1]) & ~0x7Fu), u2f(f2u(A[j + 2]) & ~0x7Fu), u2f(f2u(A[j + 3]) & ~0x7Fu)};
                *(int4*)(ci + j) = (int4){(int)(f2u(A[j]) & 0x7Fu), (int)(f2u(A[j + 1]) & 0x7Fu), (int)(f2u(A[j + 2]) & 0x7Fu), (int)(f2u(A[j + 3]) & 0x7Fu)}; } }
    }
    __syncthreads();
}
DEV void gemm_tile_mfma(const Params& p, int layer, int mode, int m0, int n0, const bf16_t* Bt, char* smem) {
    const int tid = otid(), lane = tid & 63, wave = tid >> 6, wr = wave >> 1, wc = wave & 1, c = lane & 15, g = lane >> 4;
    const bf16_t* A = p.H + (size_t)m0 * DM; const bf16_t* B = Bt + (size_t)n0 * DM;
    f32x4 acc[4][4];
#pragma unroll
    for (int i = 0; i < 4; ++i)
#pragma unroll
        for (int j = 0; j < 4; ++j) acc[i][j] = (f32x4){0.f, 0.f, 0.f, 0.f};
    u32x4 kreg[8];
    constexpr int NK = DM / 64;
#define GEMM_STAGE(kt_, st_) { char* sa_ = smem + (st_) * 32768; \
        _Pragma("unroll") for (int i = 0; i < 4; ++i) { const int q = tid + 256 * i, row = q >> 3, ch = (q & 7) ^ (row & 7); \
            __builtin_amdgcn_global_load_lds((const unsigned*)(A + (size_t)row * DM + (kt_) * 64 + ch * 8), (LAS unsigned*)(sa_ + q * 16), 16, 0, 0); \
            __builtin_amdgcn_global_load_lds((const unsigned*)(B + (size_t)row * DM + (kt_) * 64 + ch * 8), (LAS unsigned*)(sa_ + 16384 + q * 16), 16, 0, 0); } }
    GEMM_STAGE(0, 0)
    for (int kt = 0; kt < NK; ++kt) {
        char* sa = smem + (kt & 1) * 32768; char* sb = sa + 16384;
        asm volatile("s_waitcnt vmcnt(0)" ::: "memory");
        __syncthreads();
        if (kt + 1 < NK) GEMM_STAGE(kt + 1, (kt + 1) & 1)
        if (mode == 2 && kt == NK - 1) {
            const bf16_t* kb = p.KB + ((size_t)layer * 2 + ((n0 >> 7) & 1)) * NKEYS * 128;
#pragma unroll
            for (int i = 0; i < 8; ++i) { const int q = tid + 256 * i, key = q >> 4, ch = q & 15; kreg[i] = *(const u32x4*)(kb + (size_t)key * 128 + ch * 8); }
        }
        bf16x8 fa[2][4], fb[2][4];
#pragma unroll
        for (int kk = 0; kk < 2; ++kk) {
            { const int row = wr * 64 + c; fa[kk][0] = *(const bf16x8*)(sa + row * 128 + (((kk * 4 + g) ^ (row & 7)) << 4)); }
#pragma unroll
            for (int j = 0; j < 4; ++j) { const int row = wc * 64 + j * 16 + c; fb[kk][j] = *(const bf16x8*)(sb + row * 128 + (((kk * 4 + g) ^ (row & 7)) << 4)); }
#pragma unroll
            for (int i = 1; i < 4; ++i) { const int row = wr * 64 + i * 16 + c; fa[kk][i] = *(const bf16x8*)(sa + row * 128 + (((kk * 4 + g) ^ (row & 7)) << 4)); }
        }
#pragma unroll
        for (int kk = 0; kk < 2; ++kk)
#pragma unroll
            for (int i = 0; i < 4; ++i)
#pragma unroll
                for (int j = 0; j < 4; ++j) acc[i][j] = __builtin_amdgcn_mfma_f32_16x16x32_bf16(fb[kk][j], fa[kk][i], acc[i][j], 0, 0, 0);
        __builtin_amdgcn_sched_group_barrier(0x100, 8, 0);
#pragma unroll
        for (int r = 0; r < 4; ++r) { __builtin_amdgcn_sched_group_barrier(0x008, 2, 0); __builtin_amdgcn_sched_group_barrier(0x100, 2, 0); }
        __builtin_amdgcn_sched_group_barrier(0x008, 24, 0);
        __builtin_amdgcn_sched_barrier(0);
    }
#undef GEMM_STAGE
    if (mode == 2) { peer_score_epilogue(p, layer, m0, n0 >> 7, acc, smem, tid, kreg); return; }
    if (mode == 0) {
        __syncthreads();
#pragma unroll
        for (int i = 0; i < 4; ++i) { const int rl = wr * 64 + i * 16 + c;
#pragma unroll
            for (int j = 0; j < 4; ++j) { uint2 o; o.x = pack2bf(acc[i][j][0], acc[i][j][1]); o.y = pack2bf(acc[i][j][2], acc[i][j][3]); *(uint2*)(smem + rl * 272 + (wc * 64 + j * 16 + 4 * g) * 2) = o; } }
        __syncthreads();
#pragma unroll
        for (int i = 0; i < 8; ++i) { const int q = tid + 256 * i, rl = q >> 4, ch = q & 15;
            *(u32x4*)(p.P + (size_t)(m0 + rl) * INW + n0 + ch * 8) = *(const u32x4*)(smem + rl * 272 + ch * 16); }
        __syncthreads();
        return;
    }
    float4 g1v[4];
    { const float* g1 = mod_row(p, layer, m0) + 2 * DM + n0 + wc * 64 + 4 * g;
#pragma unroll
      for (int j = 0; j < 4; ++j) g1v[j] = *(const float4*)(g1 + j * 16); }
    __syncthreads();
#pragma unroll
    for (int i = 0; i < 4; ++i) { const int rl = wr * 64 + i * 16 + c;
#pragma unroll
        for (int j = 0; j < 4; ++j) { const float4 gg = g1v[j];
            uint2 o; o.x = pack2bf(gg.x * acc[i][j][0], gg.y * acc[i][j][1]); o.y = pack2bf(gg.z * acc[i][j][2], gg.w * acc[i][j][3]); *(uint2*)(smem + rl * 272 + (wc * 64 + j * 16 + 4 * g) * 2) = o; } }
    __syncthreads();
    if (layer == 0) {
        f32x4 r0[8], r1[8];
#pragma unroll
        for (int i = 0; i < 8; ++i) { const int q = tid + 256 * i, rl = q >> 4, ch = q & 15; const float* rin = resid_in(p, 0, m0 + rl) + n0 + ch * 8; r0[i] = *(const f32x4*)rin; r1[i] = *(const f32x4*)(rin + 4); }
#pragma unroll
        for (int i = 0; i < 8; ++i) { const int q = tid + 256 * i, rl = q >> 4, ch = q & 15;
            float dl[8]; unpack8(*(const u32x4*)(smem + rl * 272 + ch * 16), dl);
            *(u32x4*)(p.RB + (size_t)(m0 + rl) * DM + n0 + ch * 8) = (u32x4){pack2bf(r0[i][0] + dl[0], r0[i][1] + dl[1]), pack2bf(r0[i][2] + dl[2], r0[i][3] + dl[3]), pack2bf(r1[i][0] + dl[4], r1[i][1] + dl[5]), pack2bf(r1[i][2] + dl[6], r1[i][3] + dl[7])}; }
    } else {
        u32x4 rb[8];
#pragma unroll
        for (int i = 0; i < 8; ++i) { const int q = tid + 256 * i, rl = q >> 4, ch = q & 15; rb[i] = *(const u32x4*)(p.RB + (size_t)(m0 + rl) * DM + n0 + ch * 8); }
#pragma unroll
        for (int i = 0; i < 8; ++i) { const int q = tid + 256 * i, rl = q >> 4, ch = q & 15;
            float dl[8], rv[8]; unpack8(*(const u32x4*)(smem + rl * 272 + ch * 16), dl); unpack8(rb[i], rv);
            *(u32x4*)(p.RB + (size_t)(m0 + rl) * DM + n0 + ch * 8) = (u32x4){pack2bf(rv[0] + dl[0], rv[1] + dl[1]), pack2bf(rv[2] + dl[2], rv[3] + dl[3]), pack2bf(rv[4] + dl[4], rv[5] + dl[5]), pack2bf(rv[6] + dl[6], rv[7] + dl[7])}; }
    }
    __syncthreads();
}
DEV void st_gemm_mfma(const Params& p, int layer, int mode, bool lat_only, char* smem, int bid, int nb) {
    const bf16_t* Bt; int N; gemm_cfg(p, layer, mode, Bt, N);
    const int ntm = (lat_only ? NLAT : NTOK) / 128, ntn = N / 128;
    if ((nb & 7) == 0) {
        const int xcd = bid & 7, li = bid >> 3, nl = nb >> 3;
        const int nown = (ntm - xcd + 7) / 8;
        int base = 0;
        for (int rg = 0; rg * 8 < nown; ++rg) {
            const int nr = (nown - rg * 8) < 8 ? (nown - rg * 8) : 8;
            for (int cg = 0; cg * 8 < ntn; ++cg) {
                const int nc = (ntn - cg * 8) < 8 ? (ntn - cg * 8) : 8;
                const int ps = nr * nc;
                for (int f = base + ((li - base % nl) + nl) % nl; f < base + ps; f += nl) {
                    const int q = f - base, r = q / nc, c = q % nc;
                    gemm_tile_mfma(p, layer, mode, gemm_m0(lat_only, xcd + 8 * (rg * 8 + r)), (cg * 8 + c) * 128, Bt, smem);
                }
                base += ps;
            }
        }
    } else {
        for (int t = bid; t < ntm * ntn; t += nb) { const int tn = t % ntn, tm = t / ntn; gemm_tile_mfma(p, layer, mode, gemm_m0(lat_only, tm), tn * 128, Bt, smem); }
    }
}

DEV void st_norm_fast(const Params& p, int layer, int which, bool lat_only) {
    const int tid_ = otid(), lane = tid_ & 63, wg = blockIdx.x * 4 + (tid_ >> 6), nw = gridDim.x * 4;
    const int nrows = lat_only ? NLAT : NTOK;
    const float* g = (which ? p.norm_ffn : p.norm_mix) + (size_t)layer * DM;
    constexpr int NRF = 8;
    float4 gv[4];
#pragma unroll
    for (int j = 0; j < 4; ++j) gv[j] = ((const float4*)g)[lane + 64 * j];
    const int per = (nrows + nw - 1) / nw; const int rbeg = wg * per, rend = (rbeg + per < nrows) ? rbeg + per : nrows;
    for (int i = rbeg; i < rend; i += NRF) {
        int rows[NRF]; bool has[NRF]; float4 v[NRF][4];
#pragma unroll
        for (int u = 0; u < NRF; ++u) {
            has[u] = (i + u) < rend; const int ii = has[u] ? i + u : i; rows[u] = lat_only ? lat_row(ii) : ii;
            if (which == 0) {
                const float4* xr = (const float4*)resid_in(p, layer, rows[u]);
#pragma unroll
                for (int j = 0; j < 4; ++j) v[u][j] = xr[lane + 64 * j];
            } else {
                const uint2* xr = (const uint2*)(p.RB + (size_t)rows[u] * DM);
#pragma unroll
                for (int j = 0; j < 4; ++j) { const uint2 t = xr[lane + 64 * j]; v[u][j] = (float4){bflo(t.x), bfhi(t.x), bflo(t.y), bfhi(t.y)}; }
            }
        }
        const int ilast = (i + NRF - 1 < rend) ? i + NRF - 1 : rend - 1;
        const float* mA = mod_row(p, layer, rows[0]); const float* mB = mod_row(p, layer, lat_only ? lat_row(ilast) : ilast);
        const bool uni = (mA == mB);
        float4 scv[4], shv[4];
        if (uni) {
#pragma unroll
            for (int j = 0; j < 4; ++j) { shv[j] = ((const float4*)(mA + (which ? 3 : 0) * DM))[lane + 64 * j]; scv[j] = ((const float4*)(mA + (which ? 4 : 1) * DM))[lane + 64 * j]; }
        }
#pragma unroll
        for (int u = 0; u < NRF; ++u) {
            if (!has[u]) continue;
            const int row = rows[u];
            float ss = 0.f;
#pragma unroll
            for (int j = 0; j < 4; ++j) ss += v[u][j].x * v[u][j].x + v[u][j].y * v[u][j].y + v[u][j].z * v[u][j].z + v[u][j].w * v[u][j].w;
            ss = wave_sum(ss);
            const float rs = 1.0f / sqrtf(ss * (1.0f / DM) + EPS);
            uint2* h = (uint2*)(p.H + (size_t)row * DM);
            if (!uni) { const float* m = mod_row(p, layer, row);
#pragma unroll
                for (int j = 0; j < 4; ++j) { shv[j] = ((const float4*)(m + (which ? 3 : 0) * DM))[lane + 64 * j]; scv[j] = ((const float4*)(m + (which ? 4 : 1) * DM))[lane + 64 * j]; } }
#pragma unroll
            for (int j = 0; j < 4; ++j) { const int q = lane + 64 * j; const float4 gg = gv[j], s1 = scv[j], s0 = shv[j];
                uint2 o; o.x = pack2bf(v[u][j].x * rs * gg.x * (1.0f + s1.x) + s0.x, v[u][j].y * rs * gg.y * (1.0f + s1.y) + s0.y);
                o.y = pack2bf(v[u][j].z * rs * gg.z * (1.0f + s1.z) + s0.z, v[u][j].w * rs * gg.w * (1.0f + s1.w) + s0.w); h[q] = o; }
        }
    }
}
DEV void st_final_fast(const Params& p) {
    const int tid_ = otid(), lane = tid_ & 63, wg = blockIdx.x * 4 + (tid_ >> 6), nw = gridDim.x * 4;
    for (int i = wg; i < NLAT; i += nw) {
        float4* xr = (float4*)(p.out + (size_t)i * DM); float4 v[4]; float ss = 0.f;
#pragma unroll
        for (int j = 0; j < 4; ++j) { v[j] = xr[lane + 64 * j]; ss += v[j].x * v[j].x + v[j].y * v[j].y + v[j].z * v[j].z + v[j].w * v[j].w; }
        ss = wave_sum(ss);
        const float rs = 1.0f / sqrtf(ss * (1.0f / DM) + EPS);
#pragma unroll
        for (int j = 0; j < 4; ++j) { const float4 gg = ((const float4*)p.final_norm)[lane + 64 * j]; float4 o; o.x = v[j].x * rs * gg.x; o.y = v[j].y * rs * gg.y; o.z = v[j].z * rs * gg.z; o.w = v[j].w * rs * gg.w; xr[lane + 64 * j] = o; }
    }
}
struct MergeIn { uint2 ya, yb, cc[3], cx[3], cb, dg, o0, o1; };
DEV void merge_load(const Params& p, int row, int c4, MergeIn& m) {
    const int pp = row % TPB; const bool isctx = pp < CTXL; const int lo = isctx ? 0 : CTXL, hi = isctx ? CTXL - 1 : TPB - 1;
    const bf16_t* pr = p.P + (size_t)row * INW;
    m.ya = *(const uint2*)(p.Y + (size_t)row * 512 + c4); m.yb = *(const uint2*)(p.Y + (size_t)row * 512 + 256 + c4);
#pragma unroll
    for (int j = 0; j < 3; ++j) { const int q = pp + j - 1; const bf16_t* nr = pr + ((q >= lo && q <= hi) ? (ptrdiff_t)(j - 1) * INW : 0);
        m.cc[j] = *(const uint2*)(nr + C_CC + c4); m.cx[j] = *(const uint2*)(nr + C_CX + c4); }
    m.cb = *(const uint2*)(pr + C_CB + c4); m.dg = *(const uint2*)(pr + C_DG + c4);
    m.o0 = *(const uint2*)(p.ODH + (size_t)row * 256 + c4); m.o1 = *(const uint2*)(p.ODH + ((size_t)NTOK + row) * 256 + c4);
}
DEV void merge_compute(const Params& p, int row, int c4, const MergeIn& m, const float4 (&cwv)[3], const float4 (&gnv)[4]) {
    const int pp = row % TPB; const bool isctx = pp < CTXL; const int lo = isctx ? 0 : CTXL, hi = isctx ? CTXL - 1 : TPB - 1;
    float y[4][4];
    y[0][0] = bflo(m.ya.x); y[0][1] = bfhi(m.ya.x); y[0][2] = bflo(m.ya.y); y[0][3] = bfhi(m.ya.y); y[1][0] = bflo(m.yb.x); y[1][1] = bfhi(m.yb.x); y[1][2] = bflo(m.yb.y); y[1][3] = bfhi(m.yb.y);
    { float acc[4] = {0.f, 0.f, 0.f, 0.f};
#pragma unroll
      for (int j = 0; j < 3; ++j) { const int q = pp + j - 1; const float ok = (q >= lo && q <= hi) ? 1.0f : 0.0f; const float4 w = cwv[j];
          acc[0] += ok * w.x * bflo(m.cc[j].x) * bflo(m.cx[j].x); acc[1] += ok * w.y * bfhi(m.cc[j].x) * bfhi(m.cx[j].x); acc[2] += ok * w.z * bflo(m.cc[j].y) * bflo(m.cx[j].y); acc[3] += ok * w.w * bfhi(m.cc[j].y) * bfhi(m.cx[j].y); }
      y[2][0] = bflo(m.cb.x) * acc[0]; y[2][1] = bfhi(m.cb.x) * acc[1]; y[2][2] = bflo(m.cb.y) * acc[2]; y[2][3] = bfhi(m.cb.y) * acc[3]; }
    y[3][0] = (bflo(m.o0.x) + bflo(m.o1.x)) * siluf_(bflo(m.dg.x)); y[3][1] = (bfhi(m.o0.x) + bfhi(m.o1.x)) * siluf_(bfhi(m.dg.x));
    y[3][2] = (bflo(m.o0.y) + bflo(m.o1.y)) * siluf_(bflo(m.dg.y)); y[3][3] = (bfhi(m.o0.y) + bfhi(m.o1.y)) * siluf_(bfhi(m.dg.y));
#pragma unroll
    for (int g = 0; g < 4; ++g) {
        float ss = y[g][0] * y[g][0] + y[g][1] * y[g][1] + y[g][2] * y[g][2] + y[g][3] * y[g][3]; ss = wave_sum(ss);
        const float rs = 1.0f / sqrtf(ss * (1.0f / 256.0f) + EPS); const float4 gg = gnv[g];
        uint2 o; o.x = pack2bf(y[g][0] * rs * gg.x, y[g][1] * rs * gg.y); o.y = pack2bf(y[g][2] * rs * gg.z, y[g][3] * rs * gg.w);
        *(uint2*)(p.H + (size_t)row * DM + g * 256 + c4) = o;
    }
}
DEV void st_merge_fast(const Params& p, int layer, bool lat_only) {
    const int tid_ = otid(), lane = tid_ & 63, wg = blockIdx.x * 4 + (tid_ >> 6), nw = gridDim.x * 4;
    const int nrows = lat_only ? NLAT : NTOK; const int c4 = 4 * lane;
    const float* cw = p.conv_w + (size_t)layer * 3 * 256; const float* gn = p.group_norm + (size_t)layer * DM;
    float4 cwv[3], gnv[4];
#pragma unroll
    for (int j = 0; j < 3; ++j) cwv[j] = *(const float4*)(cw + j * 256 + c4);
#pragma unroll
    for (int g = 0; g < 4; ++g) gnv[g] = *(const float4*)(gn + g * 256 + c4);
    for (int i = wg; i < nrows; i += 4 * nw) {
        int rows[4]; bool has[4]; MergeIn mi[4];
#pragma unroll
        for (int u = 0; u < 4; ++u) { has[u] = (i + u * nw) < nrows; const int ii = has[u] ? i + u * nw : i; rows[u] = lat_only ? lat_row(ii) : ii; merge_load(p, rows[u], c4, mi[u]); }
#pragma unroll
        for (int u = 0; u < 4; ++u) if (has[u]) merge_compute(p, rows[u], c4, mi[u], cwv, gnv);
    }
}
constexpr int HTB = 32;
constexpr int HNZ = HTB * 8, HNCH = 2 * HNZ + HTB * 4, HNR = (HNCH + 255) / 256;
constexpr int HST = HTB * 64 * 2 + HTB * 32;
DEV int hgrn_pp(int st, int dir) { if (st < CTXL) return dir ? CTXL - 1 - st : st; const int t = st - CTXL; return CTXL + (dir ? SEQ - 1 - t : t); }
DEV void hgrn_chunk(int cid, int vhalf, int& arr, int& s, int& ch) { if (cid < 2 * HNZ) { arr = cid / HNZ; s = (cid % HNZ) >> 3; ch = (cid & 7) * 8; } else { arr = 2; s = (cid - 2 * HNZ) >> 2; ch = vhalf * 32 + ((cid - 2 * HNZ) & 3) * 8; } }
DEV void hgrn_gates(const u32x4 (&r)[HNR], int tid, int vhalf, float* stage, const float* lbs) {
#pragma unroll
    for (int cix = 0; cix < HNR; ++cix) {
        const int cid = tid + 256 * cix; if (cid >= HNCH) break;
        int arr, s, ch; hgrn_chunk(cid, vhalf, arr, s, ch);
        float x[8]; unpack8(r[cix], x);
        if (arr == 0) {
            float f[8];
#pragma unroll
            for (int j = 0; j < 8; ++j) { const float lb = lbs[ch + j]; const float sg = 1.0f / (1.0f + __expf(-x[j])); f[j] = lb + (1.0f - lb) * sg; }
            float* F = stage + s * 64 + ch;
            *(float4*)F = (float4){f[0], f[1], f[2], f[3]}; *(float4*)(F + 4) = (float4){f[4], f[5], f[6], f[7]};
        } else {
            float* D = (arr == 1) ? stage + HTB * 64 + s * 64 + ch : stage + 2 * HTB * 64 + s * 32 + (ch - vhalf * 32);
            *(float4*)D = (float4){x[0], x[1], x[2], x[3]}; *(float4*)(D + 4) = (float4){x[4], x[5], x[6], x[7]};
        }
    }
}
DEV void hgrn_issue(const Params& p, const bf16_t* Pb, int h, int dir, int vhalf, int bt, int tid, u32x4 (&r)[HNR]) {
#pragma unroll
    for (int cix = 0; cix < HNR; ++cix) {
        const int cid = tid + 256 * cix; if (cid >= HNCH) break;
        int arr, s, ch; hgrn_chunk(cid, vhalf, arr, s, ch);
        const int col = (arr == 0 ? (dir ? C_DZB : C_DZF) : (arr == 1 ? C_DQ : C_DI)) + h * 64 + ch;
        r[cix] = *(const u32x4*)(Pb + (size_t)hgrn_pp(bt * HTB + s, dir) * INW + col);
    }
}
DEV void st_hgrn_item(const Params& p, int layer, char* smem, int item) {
    const int tid = otid(), lane = tid & 63, w = tid >> 6, dg = lane & 15, vg = lane >> 4;
    float* stg = (float*)smem;
    float* Ol = stg + 2 * HST;
    float* lbs = Ol + HTB * 32;
    constexpr int NB = TPB / HTB;
    {
        const int vhalf = item & 1, dir = (item >> 1) & 1, h = (item >> 2) & 3, b = item >> 4;
        const bf16_t* Pb = p.P + (size_t)b * TPB * INW;
        __syncthreads();
        if (tid < 64) lbs[tid] = hgrn_lb(p, layer, h * 64 + tid);
        __syncthreads();
        u32x4 r[HNR];
        hgrn_issue(p, Pb, h, dir, vhalf, 0, tid, r);
        hgrn_gates(r, tid, vhalf, stg, lbs);
        __syncthreads();
        float S[4][2];
#pragma unroll
        for (int i = 0; i < 4; ++i) { S[i][0] = 0.f; S[i][1] = 0.f; }
        for (int bt = 0; bt < NB; ++bt) {
            if (bt + 1 < NB) hgrn_issue(p, Pb, h, dir, vhalf, bt + 1, tid, r);
            const float* st = stg + (bt & 1) * HST;
#define HG_LOAD(F_, Q_, V_, S0) { _Pragma("unroll") for (int u = 0; u < 4; ++u) { const int s_ = (S0) + u; \
                F_[u] = *(const float4*)(st + s_ * 64 + 4 * dg); Q_[u] = *(const float4*)(st + HTB * 64 + s_ * 64 + 4 * dg); V_[u] = *(const float2*)(st + 2 * HTB * 64 + s_ * 32 + 8 * w + 2 * vg); } }
#define HG_COMP(F_, Q_, V_, S0) { float x[8]; \
                _Pragma("unroll") for (int u = 0; u < 4; ++u) { \
                    const float ff[4] = {F_[u].x, F_[u].y, F_[u].z, F_[u].w}, qq[4] = {Q_[u].x, Q_[u].y, Q_[u].z, Q_[u].w}; const float v0 = V_[u].x, v1 = V_[u].y; \
                    float pa = 0.f, pb = 0.f; \
                    _Pragma("unroll") for (int i = 0; i < 4; ++i) { S[i][0] = fmaf(ff[i], S[i][0] - v0, v0); S[i][1] = fmaf(ff[i], S[i][1] - v1, v1); pa = fmaf(S[i][0], qq[i], pa); pb = fmaf(S[i][1], qq[i], pb); } \
                    x[2 * u] = pa; x[2 * u + 1] = pb; } \
                float y[4], z[2]; \
                _Pragma("unroll") for (int k = 0; k < 4; ++k) { const float kp = b3 ? x[4 + k] : x[k], sd = b3 ? x[k] : x[4 + k]; y[k] = kp + dppf<0x140>(sd); } \
                _Pragma("unroll") for (int k = 0; k < 2; ++k) { const float kp = b2 ? y[2 + k] : y[k], sd = b2 ? y[k] : y[2 + k]; z[k] = kp + dppf<0x141>(sd); } \
                const float kp_ = b1 ? z[1] : z[0], sd_ = b1 ? z[0] : z[1]; float t = kp_ + dppf<0x4E>(sd_); \
                t += dppf<0xB1>(t); \
                if ((dg & 1) == 0) Ol[((S0) + (vi >> 1)) * 32 + 8 * w + 2 * vg + (vi & 1)] = t; }
            { const bool b3 = (dg & 8) != 0, b2 = (dg & 4) != 0, b1 = (dg & 2) != 0; const int vi = dg >> 1;
              float4 Fa[4], Qa[4], Fb[4], Qb[4]; float2 Va[4], Vb[4];
              HG_LOAD(Fa, Qa, Va, 0)
              for (int s0 = 0; s0 < HTB; s0 += 8) {
                  HG_LOAD(Fb, Qb, Vb, s0 + 4)
                  HG_COMP(Fa, Qa, Va, s0)
                  if (s0 + 8 < HTB) HG_LOAD(Fa, Qa, Va, s0 + 8)
                  HG_COMP(Fb, Qb, Vb, s0 + 4)
              } }
#undef HG_LOAD
#undef HG_COMP
            __syncthreads();
#pragma unroll
            for (int e = tid; e < HTB * 8; e += 256) { const int s = e >> 3, v4 = (e & 7) * 4; const int pp = hgrn_pp(bt * HTB + s, dir);
              *(float4*)(p.OD + ((size_t)dir * NTOK + (size_t)b * TPB + pp) * 256 + h * 64 + vhalf * 32 + v4) = *(const float4*)(Ol + s * 32 + v4); }
            if (bt + 1 < NB) hgrn_gates(r, tid, vhalf, stg + ((bt + 1) & 1) * HST, lbs);
            __syncthreads();
        }
    }
}
constexpr int HM_ROW = 144;
constexpr int HM_OQ = 0, HM_OK = 32 * HM_ROW, HM_OKT = 2 * 32 * HM_ROW, HM_OVT = HM_OKT + 4096, HM_OPR = HM_OVT + 4096, HM_OPE = HM_OPR + 512, HM_STG = HM_OPE + 512;
constexpr int HM_OF = 2 * HM_STG, HM_OQF = HM_OF + 8192, HM_OLB = HM_OQF + 8192;
static_assert(HM_OLB + 256 <= 65536, "hgrn LDS");
DEV void hgrnm_issue(const bf16_t* Pb, int h, int dir, int bt, int tid, u32x4 (&r)[3]) {
    const int s = tid >> 3, ch = (tid & 7) * 8;
    const bf16_t* row = Pb + (size_t)hgrn_pp(bt * 32 + s, dir) * INW + h * 64 + ch;
    r[0] = *(const u32x4*)(row + (dir ? C_DZB : C_DZF)); r[1] = *(const u32x4*)(row + C_DQ); r[2] = *(const u32x4*)(row + C_DI);
}
DEV void hgrnm_prep_a(const u32x4 (&r)[3], int tid, char* smem, char* stage) {
    const int s = tid >> 3, ch = (tid & 7) * 8; const float* lbs = (const float*)(smem + HM_OLB);
    float x[8], f[8];
    unpack8(r[0], x);
#pragma unroll
    for (int j = 0; j < 8; ++j) { const float lb = lbs[ch + j]; const float sg = __builtin_amdgcn_rcpf(1.0f + __expf(-x[j])); f[j] = lb + (1.0f - lb) * sg; }
    float* F = (float*)(smem + HM_OF) + s * 64 + ch;
    *(float4*)F = (float4){f[0], f[1], f[2], f[3]}; *(float4*)(F + 4) = (float4){f[4], f[5], f[6], f[7]};
    unpack8(r[1], x);
    float* Q = (float*)(smem + HM_OQF) + s * 64 + ch;
    *(float4*)Q = (float4){x[0], x[1], x[2], x[3]}; *(float4*)(Q + 4) = (float4){x[4], x[5], x[6], x[7]};
    bf16_t* vt = (bf16_t*)(stage + HM_OVT) + ((s >> 4) * 64 + ch) * 16 + (s & 15);
    const unsigned w4[4] = {r[2].x, r[2].y, r[2].z, r[2].w};
#pragma unroll
    for (int j = 0; j < 4; ++j) { vt[(2 * j) * 16] = (bf16_t)(w4[j] & 0xffffu); vt[(2 * j + 1) * 16] = (bf16_t)(w4[j] >> 16); }
}
DEV void hgrnm_prep_b(int tid, char* smem, char* stage) {
    const int d = tid & 63, c = (tid >> 6) & 1, half = tid >> 7;
    const float* F = (const float*)(smem + HM_OF) + (c * 16) * 64 + d; const float* Q = (const float*)(smem + HM_OQF) + (c * 16) * 64 + d;
    bf16_t* qs = (bf16_t*)(stage + HM_OQ); bf16_t* ks = (bf16_t*)(stage + HM_OK);
    unsigned kt[4];
    float fv[8], qv8[8];
#pragma unroll
    for (int t = 0; t < 8; ++t) { fv[t] = F[(half * 8 + t) * 64]; qv8[t] = Q[(half * 8 + t) * 64]; }
    __builtin_amdgcn_sched_barrier(0);
    if (half == 0) {
        float up = 1.0f, fl = 1.0f;
#pragma unroll
        for (int t = 7; t >= 0; --t) {
            const float f = fv[t], q = qv8[t];
            const float qv = q * __builtin_amdgcn_rcpf(fmaxf(up, 1.0e-37f)), kv = (1.0f - f) * up;
            const unsigned qk = pack2bf(qv, kv); const bf16_t qb = (bf16_t)(qk & 0xffffu), kb = (bf16_t)(qk >> 16);
            qs[(c * 16 + t) * (HM_ROW / 2) + d] = qb; ks[(c * 16 + t) * (HM_ROW / 2) + d] = kb;
            if (t & 1) kt[t >> 1] = (unsigned)kb << 16; else kt[t >> 1] |= (unsigned)kb;
            fl = f; if (t > 0) up *= f;
        }
        ((float*)(stage + HM_OPR))[c * 64 + d] = up * fl;
    } else {
        float dn = 1.0f;
#pragma unroll
        for (int t = 8; t < 16; ++t) {
            const float f = fv[t - 8], q = qv8[t - 8];
            dn *= f;
            const float qv = q * dn, kv = (1.0f - f) * __builtin_amdgcn_rcpf(fmaxf(dn, 1.0e-37f));
            const unsigned qk = pack2bf(qv, kv); const bf16_t qb = (bf16_t)(qk & 0xffffu), kb = (bf16_t)(qk >> 16);
            qs[(c * 16 + t) * (HM_ROW / 2) + d] = qb; ks[(c * 16 + t) * (HM_ROW / 2) + d] = kb;
            if (t & 1) kt[(t - 8) >> 1] |= (unsigned)kb << 16; else kt[(t - 8) >> 1] = (unsigned)kb;
        }
        ((float*)(stage + HM_OPE))[c * 64 + d] = dn;
    }
    *(u32x4*)(stage + HM_OKT + ((c * 64 + d) * 16 + half * 8) * 2) = (u32x4){kt[0], kt[1], kt[2], kt[3]};
}
DEV void hgrnm_batch(const bf16_t* Pb, bf16_t* odb, char* smem, int h, int dir, int bt, int nbt, int tid, int w, int cl, int g, u32x4 (&rf)[3], const u32x4 (&rn)[3], f32x4 (&S)[4]) {
    if (bt + 4 < nbt) hgrnm_issue(Pb, h, dir, bt + 4, tid, rf);
    const char* stg = smem + (bt & 1) * HM_STG;
    u32x4 vfq[2]; f32x4 oi[2];
    { bf16x8 kf[2][2], qf[2][2]; uint2 vfr[2];
#pragma unroll
      for (int c = 0; c < 2; ++c) {
          const char* qrow = stg + HM_OQ + (c * 16 + cl) * HM_ROW; const char* krow = stg + HM_OK + (c * 16 + cl) * HM_ROW;
#pragma unroll
          for (int kk = 0; kk < 2; ++kk) { kf[c][kk] = *(const bf16x8*)(krow + (32 * kk + 8 * g) * 2); qf[c][kk] = *(const bf16x8*)(qrow + (32 * kk + 8 * g) * 2); }
          vfr[c] = *(const uint2*)(stg + HM_OVT + ((c * 64 + 16 * w + cl) * 16 + 4 * g) * 2);
      }
      __builtin_amdgcn_sched_barrier(0);
      f32x4 at[2];
#pragma unroll
      for (int c = 0; c < 2; ++c) { at[c] = (f32x4){0.f, 0.f, 0.f, 0.f};
#pragma unroll
          for (int kk = 0; kk < 2; ++kk) at[c] = __builtin_amdgcn_mfma_f32_16x16x32_bf16(kf[c][kk], qf[c][kk], at[c], 0, 0, 0); }
#pragma unroll
      for (int c = 0; c < 2; ++c) {
          u32x4 pa;
          pa.x = pack2bf((4 * g + 0 <= cl) ? at[c][0] : 0.f, (4 * g + 1 <= cl) ? at[c][1] : 0.f); pa.y = pack2bf((4 * g + 2 <= cl) ? at[c][2] : 0.f, (4 * g + 3 <= cl) ? at[c][3] : 0.f); pa.z = 0u; pa.w = 0u;
          vfq[c] = (u32x4){vfr[c].x, vfr[c].y, 0u, 0u};
          oi[c] = __builtin_amdgcn_mfma_f32_16x16x32_bf16(__builtin_bit_cast(bf16x8, pa), __builtin_bit_cast(bf16x8, vfq[c]), (f32x4){0.f, 0.f, 0.f, 0.f}, 0, 0, 0);
      } }
    const int pp0 = hgrn_pp(bt * 32, dir), sgp = dir ? -1 : 1;
#pragma unroll
    for (int c = 0; c < 2; ++c) {
        uint2 qp0[2], qp1[2], kar[4]; float4 prv[4], pev[4];
        { const char* qrow = stg + HM_OQ + (c * 16 + cl) * HM_ROW;
#pragma unroll
          for (int kk = 0; kk < 2; ++kk) { qp0[kk] = *(const uint2*)(qrow + (16 * (2 * kk) + 4 * g) * 2); qp1[kk] = *(const uint2*)(qrow + (16 * (2 * kk + 1) + 4 * g) * 2); }
#pragma unroll
          for (int j = 0; j < 4; ++j) { prv[j] = *(const float4*)(stg + HM_OPR + (c * 64 + 16 * j + 4 * g) * 4); pev[j] = *(const float4*)(stg + HM_OPE + (c * 64 + 16 * j + 4 * g) * 4);
              kar[j] = *(const uint2*)(stg + HM_OKT + ((c * 64 + 16 * j + cl) * 16 + 4 * g) * 2); } }
#pragma unroll
        for (int j = 0; j < 4; ++j) { S[j][0] *= prv[j].x; S[j][1] *= prv[j].y; S[j][2] *= prv[j].z; S[j][3] *= prv[j].w; }
        f32x4 o = oi[c];
#pragma unroll
        for (int kk = 0; kk < 2; ++kk) {
            const u32x4 qa = (u32x4){qp0[kk].x, qp0[kk].y, qp1[kk].x, qp1[kk].y};
            const u32x4 sb = (u32x4){pack2bf(S[2 * kk][0], S[2 * kk][1]), pack2bf(S[2 * kk][2], S[2 * kk][3]), pack2bf(S[2 * kk + 1][0], S[2 * kk + 1][1]), pack2bf(S[2 * kk + 1][2], S[2 * kk + 1][3])};
            o = __builtin_amdgcn_mfma_f32_16x16x32_bf16(__builtin_bit_cast(bf16x8, qa), __builtin_bit_cast(bf16x8, sb), o, 0, 0, 0);
        }
#pragma unroll
        for (int j = 0; j < 4; ++j) {
            const u32x4 ka = (u32x4){kar[j].x, kar[j].y, 0u, 0u};
            S[j] = __builtin_amdgcn_mfma_f32_16x16x32_bf16(__builtin_bit_cast(bf16x8, ka), __builtin_bit_cast(bf16x8, vfq[c]), S[j], 0, 0, 0);
            S[j][0] *= pev[j].x; S[j][1] *= pev[j].y; S[j][2] *= pev[j].z; S[j][3] *= pev[j].w;
        }
#pragma unroll
        for (int i = 0; i < 4; ++i) odb[(ptrdiff_t)(pp0 + sgp * (c * 16 + 4 * g + i)) * 256] = f2bf_hw(o[i]);
    }
    if (bt + 1 < nbt) {
        char* nst = smem + ((bt + 1) & 1) * HM_STG;
        hgrnm_prep_a(rn, tid, smem, nst);
        __syncthreads();
        hgrnm_prep_b(tid, smem, nst);
    }
    __syncthreads();
}
DEV void st_hgrn_mfma(const Params& p, int layer, char* smem, int item) {
    const int tid = otid(), lane = tid & 63, w = tid >> 6, cl = lane & 15, g = lane >> 4;
    constexpr int NB = TPB / 32;
    static_assert(NB % 4 == 0, "hgrn batch ring");
    const int dir = item & 1, h = (item >> 1) & 3, b = item >> 3;
    const bf16_t* Pb = p.P + (size_t)b * TPB * INW;
    __builtin_amdgcn_s_setprio(3);
    __syncthreads();
    if (tid < 64) ((float*)(smem + HM_OLB))[tid] = hgrn_lb(p, layer, h * 64 + tid);
    __syncthreads();
    u32x4 r0[3], r1[3], r2[3], r3[3];
    hgrnm_issue(Pb, h, dir, 0, tid, r0); hgrnm_issue(Pb, h, dir, 1, tid, r1); hgrnm_issue(Pb, h, dir, 2, tid, r2); hgrnm_issue(Pb, h, dir, 3, tid, r3);
    hgrnm_prep_a(r0, tid, smem, smem);
    __syncthreads();
    hgrnm_prep_b(tid, smem, smem);
    __syncthreads();
    f32x4 S[4];
#pragma unroll
    for (int j = 0; j < 4; ++j) S[j] = (f32x4){0.f, 0.f, 0.f, 0.f};
    bf16_t* odb = p.ODH + ((size_t)dir * NTOK + (size_t)b * TPB) * 256 + h * 64 + 16 * w + cl;
    for (int bt = 0; bt < NB; bt += 4) {
        hgrnm_batch(Pb, odb, smem, h, dir, bt, NB, tid, w, cl, g, r0, r1, S);
        hgrnm_batch(Pb, odb, smem, h, dir, bt + 1, NB, tid, w, cl, g, r1, r2, S);
        hgrnm_batch(Pb, odb, smem, h, dir, bt + 2, NB, tid, w, cl, g, r2, r3, S);
        hgrnm_batch(Pb, odb, smem, h, dir, bt + 3, NB, tid, w, cl, g, r3, r0, S);
    }
    __builtin_amdgcn_s_setprio(0);
}
DEV void st_peer_expert_fast(const Params& p, int layer, bool lat_only) {
    const int tid_ = otid(), lane = tid_ & 63, wg = blockIdx.x * 4 + (tid_ >> 6), nw = gridDim.x * 4;
    const int nrows = lat_only ? NLAT : NTOK;
    for (int i = wg; i < nrows; i += nw) {
        const int row = lat_only ? lat_row(i) : i;
        float hf[16], acc[16];
        { const bf16_t* hp = p.H + (size_t)row * DM; const u32x4 h0 = *(const u32x4*)(hp + 8 * lane), h1 = *(const u32x4*)(hp + 512 + 8 * lane); unpack8(h0, hf); unpack8(h1, hf + 8); }
#pragma unroll
        for (int k = 0; k < 16; ++k) acc[k] = 0.f;
        const int* idx = p.IDX + (size_t)row * PE; const float* gate = p.GATE + (size_t)row * PE;
        for (int e0 = 0; e0 < PE; e0 += 4) {
            u32x4 ur[4][2], vr[4][2]; float gt[4];
#pragma unroll
            for (int j = 0; j < 4; ++j) { const int id = __builtin_amdgcn_readfirstlane(idx[e0 + j]); gt[j] = gate[e0 + j];
                const bf16_t* up = p.UB + (size_t)id * DM; const bf16_t* vp = p.VB + (size_t)id * DM;
                ur[j][0] = *(const u32x4*)(up + 8 * lane); ur[j][1] = *(const u32x4*)(up + 512 + 8 * lane); vr[j][0] = *(const u32x4*)(vp + 8 * lane); vr[j][1] = *(const u32x4*)(vp + 512 + 8 * lane); }
#pragma unroll
            for (int j = 0; j < 4; ++j) {
                float x[16]; unpack8(ur[j][0], x); unpack8(ur[j][1], x + 8); float d = 0.f;
#pragma unroll
                for (int k = 0; k < 16; ++k) d += hf[k] * x[k];
                d = wave_sum(d);
                const float a = gt[j] * gelu_tanh_(d);
                unpack8(vr[j][0], x); unpack8(vr[j][1], x + 8);
#pragma unroll
                for (int k = 0; k < 16; ++k) acc[k] += a * x[k];
            }
        }
        float* xr = resid_out(p, row); const float* g2 = mod_row(p, layer, row) + 5 * DM;
#pragma unroll
        for (int hh = 0; hh < 2; ++hh)
#pragma unroll
            for (int q = 0; q < 2; ++q) { const int e = hh * 512 + 8 * lane + 4 * q; float4 xv = *(float4*)(xr + e); const float4 gg = *(const float4*)(g2 + e);
                xv.x += gg.x * acc[hh * 8 + 4 * q]; xv.y += gg.y * acc[hh * 8 + 4 * q + 1]; xv.z += gg.z * acc[hh * 8 + 4 * q + 2]; xv.w += gg.w * acc[hh * 8 + 4 * q + 3]; *(float4*)(xr + e) = xv; }
    }
}

typedef short s16x4 __attribute__((ext_vector_type(4)));
constexpr int AT_ROWB = 160;
constexpr int AT_TILE = 64 * AT_ROWB;
constexpr int AT_STAGE = 2 * AT_TILE;
struct AttnUnit { int type, b, h, qrow0, qpos0, ntiles, rp; bool rope, has_sink; int qcol, kcol, vcol, ycol; float sink; };
DEV float shfl_xor_f(float x, int m) { return __shfl_xor(x, m, 64); }
DEV void attn_issue(const Params& p, const AttnUnit& u, int tb, int kp0, int tid, u32x4 (&rk)[4], u32x4 (&rv)[2]) {
    const int j = tid >> 2, cq = tid & 3; const bf16_t* pr = p.P + (size_t)(tb + j) * INW;
    rk[0] = *(const u32x4*)(pr + u.kcol + 16 * cq); rk[1] = *(const u32x4*)(pr + u.kcol + 16 * cq + 8);
    if (u.rope && kp0 >= 0) { rk[2] = *(const u32x4*)(pr + u.kcol + 16 * (cq ^ 1)); rk[3] = *(const u32x4*)(pr + u.kcol + 16 * (cq ^ 1) + 8); }
    rv[0] = *(const u32x4*)(pr + u.vcol + 16 * cq); rv[1] = *(const u32x4*)(pr + u.vcol + 16 * cq + 8);
}
DEV void attn_write(const Params& p, const AttnUnit& u, int kp0, int tid, const u32x4 (&rk)[4], const u32x4 (&rv)[2], char* stage) {
    const int j = tid >> 2, cq = tid & 3; char* kd = stage + j * AT_ROWB + cq * 32; char* vd = stage + AT_TILE + j * AT_ROWB + cq * 32;
    if (u.rope && kp0 >= 0) {
        const int kp = kp0 + j; const int pos = (cq < 2) ? (kp >> 6) : (kp & 63); const float sgn = (cq & 1) ? 1.0f : -1.0f;
        float xo[16], xp[16]; unpack8(rk[0], xo); unpack8(rk[1], xo + 8); unpack8(rk[2], xp); unpack8(rk[3], xp + 8);
        const float4* cs = (const float4*)(p.ROPE + pos * 16); const float4* sn = (const float4*)(p.ROPE + 1024 + pos * 16);
        float o[16];
#pragma unroll
        for (int q = 0; q < 4; ++q) { const float4 c4 = cs[q], s4 = sn[q];
            o[4 * q] = xo[4 * q] * c4.x + sgn * xp[4 * q] * s4.x; o[4 * q + 1] = xo[4 * q + 1] * c4.y + sgn * xp[4 * q + 1] * s4.y;
            o[4 * q + 2] = xo[4 * q + 2] * c4.z + sgn * xp[4 * q + 2] * s4.z; o[4 * q + 3] = xo[4 * q + 3] * c4.w + sgn * xp[4 * q + 3] * s4.w; }
        u32x4 a, b; a.x = pack2bf(o[0], o[1]); a.y = pack2bf(o[2], o[3]); a.z = pack2bf(o[4], o[5]); a.w = pack2bf(o[6], o[7]);
        b.x = pack2bf(o[8], o[9]); b.y = pack2bf(o[10], o[11]); b.z = pack2bf(o[12], o[13]); b.w = pack2bf(o[14], o[15]);
        *(u32x4*)kd = a; *(u32x4*)(kd + 16) = b;
    } else { *(u32x4*)kd = rk[0]; *(u32x4*)(kd + 16) = rk[1]; }
    *(u32x4*)vd = rv[0]; *(u32x4*)(vd + 16) = rv[1];
}
DEV void attn_tile(const AttnUnit& u, int ti, int& tb, int& kp0) {
    const int nloc = u.ntiles - CTXL / 64;
    if (ti < nloc) { kp0 = u.qpos0 + u.rp + 64 * ti; tb = u.b * TPB + CTXL + kp0; }
    else { kp0 = -1; tb = u.b * TPB + 64 * (ti - nloc); }
}
DEV void attn_unit(const Params& p, int layer, const AttnUnit& u, char* smem) {
    const int tid = otid(), lane = tid & 63, w = tid >> 6, c = lane & 15, g = lane >> 4;
    char* stg = smem; float* rpbs = (float*)(smem + 2 * AT_STAGE);
    __syncthreads();
    if (u.type == 1) { const float* rpb = p.na_rpb + ((size_t)layer * 4 + u.h) * 465; for (int i = tid; i < 465; i += 256) rpbs[i] = rpb[i]; }
    u32x4 rk[4], rv[2]; int tb, kp0, kp0n = -1;
    attn_tile(u, 0, tb, kp0);
    attn_issue(p, u, tb, kp0, tid, rk, rv);
    bf16x8 qf[2][2];
#pragma unroll
    for (int qt = 0; qt < 2; ++qt) {
        const int qi = 32 * w + 16 * qt + c; const bf16_t* qr = p.P + (size_t)(u.qrow0 + qi) * INW + u.qcol;
#pragma unroll
        for (int kk = 0; kk < 2; ++kk) {
            const u32x4 own = *(const u32x4*)(qr + 32 * kk + 8 * g); float xo[8], o[8]; unpack8(own, xo);
            if (u.rope) {
                const u32x4 par = *(const u32x4*)(qr + 32 * kk + 8 * (g ^ 2)); float xp[8]; unpack8(par, xp);
                const int t = u.qpos0 + qi; const int pos = kk ? (t & 63) : (t >> 6); const float sgn = (g & 2) ? 1.0f : -1.0f;
                const float* cs = p.ROPE + pos * 16 + 8 * (g & 1); const float* sn = p.ROPE + 1024 + pos * 16 + 8 * (g & 1);
#pragma unroll
                for (int j = 0; j < 8; ++j) o[j] = (xo[j] * cs[j] + sgn * xp[j] * sn[j]) * 0.125f;
            } else {
#pragma unroll
                for (int j = 0; j < 8; ++j) o[j] = xo[j] * 0.125f;
            }
            u32x4 pk; pk.x = pack2bf(o[0], o[1]); pk.y = pack2bf(o[2], o[3]); pk.z = pack2bf(o[4], o[5]); pk.w = pack2bf(o[6], o[7]);
            qf[qt][kk] = __builtin_bit_cast(bf16x8, pk);
        }
    }
    f32x4 O[4][2]; float m[2], l[2];
#pragma unroll
    for (int i = 0; i < 4; ++i) { O[i][0] = (f32x4){0.f, 0.f, 0.f, 0.f}; O[i][1] = (f32x4){0.f, 0.f, 0.f, 0.f}; }
    m[0] = m[1] = MASKV; l[0] = l[1] = 0.f;
    attn_write(p, u, kp0, tid, rk, rv, stg);
    __syncthreads();
    for (int ti = 0; ti < u.ntiles; ++ti) {
        if (ti + 1 < u.ntiles) { attn_tile(u, ti + 1, tb, kp0n); attn_issue(p, u, tb, kp0n, tid, rk, rv); }
        const char* ks = stg + (ti & 1) * AT_STAGE; const char* vs = ks + AT_TILE;
        bool tskip = false, tmask = true;
        if (kp0 >= 0) {
            const int wv = __builtin_amdgcn_readfirstlane(w);
            if (u.type == 0) { const int qlo = u.qpos0 + 32 * wv, qhi = qlo + 31, klo = kp0, khi = kp0 + 63;
                tskip = (qlo - khi > 128) || (klo - qhi > 128); tmask = (qhi - klo > 128) || (khi - qlo > 128); }
            else if (u.type == 1) { const int rq = (u.qpos0 >> 6) + (wv >> 1); const int rs = clampi(rq - 4, 0, ROWS - 8); const int kr = kp0 >> 6; tskip = (kr < rs) || (kr >= rs + 8); }
        }
        if (!tskip) {
        f32x4 S[4][2];
#pragma unroll
        for (int kt = 0; kt < 4; ++kt) {
            const bf16x8 ka = *(const bf16x8*)(ks + (16 * kt + c) * AT_ROWB + 16 * g), kb = *(const bf16x8*)(ks + (16 * kt + c) * AT_ROWB + 64 + 16 * g);
#pragma unroll
            for (int qt = 0; qt < 2; ++qt) { f32x4 a = (f32x4){0.f, 0.f, 0.f, 0.f}; a = __builtin_amdgcn_mfma_f32_16x16x32_bf16(ka, qf[qt][0], a, 0, 0, 0); a = __builtin_amdgcn_mfma_f32_16x16x32_bf16(kb, qf[qt][1], a, 0, 0, 0); S[kt][qt] = a; }
        }
        if (kp0 >= 0) {
            if (u.type == 0 && tmask) {
#pragma unroll
                for (int qt = 0; qt < 2; ++qt) { const int qp = u.qpos0 + 32 * w + 16 * qt + c;
#pragma unroll
                    for (int kt = 0; kt < 4; ++kt)
#pragma unroll
                        for (int r = 0; r < 4; ++r) { const int d = qp - (kp0 + 16 * kt + 4 * g + r); if (d > 128 || d < -128) S[kt][qt][r] = MASKV; } }
            } else if (u.type == 1) {
                const int kr = kp0 >> 6;
#pragma unroll
                for (int qt = 0; qt < 2; ++qt) { const int qi = 32 * w + 16 * qt + c; const int rq = (u.qpos0 >> 6) + (qi >> 6), qc = qi & 63; const int rs = clampi(rq - 4, 0, ROWS - 8), w0 = clampi(qc - 8, 0, GRIDW - 16);
                    const bool rowok = (kr >= rs) && (kr < rs + 8); const int boff = (kr - rq + 7) * 31 - qc + 15;
#pragma unroll
                    for (int kt = 0; kt < 4; ++kt)
#pragma unroll
                        for (int r = 0; r < 4; ++r) { const int kc = 16 * kt + 4 * g + r; const bool ok = rowok && (kc >= w0) && (kc < w0 + 16); const int bi = ok ? boff + kc : 0; const float bv = rpbs[bi]; S[kt][qt][r] = ok ? S[kt][qt][r] + bv : MASKV; } }
            }
        }
        bf16x8 pf[2][2];
#pragma unroll
        for (int qt = 0; qt < 2; ++qt) {
            float mx = S[0][qt][0];
#pragma unroll
            for (int kt = 0; kt < 4; ++kt)
#pragma unroll
                for (int r = 0; r < 4; ++r) mx = fmaxf(mx, S[kt][qt][r]);
            mx = fmaxf(mx, shfl_xor_f(mx, 16)); mx = fmaxf(mx, shfl_xor_f(mx, 32));
            const float mn = fmaxf(m[qt], mx); const float al = __expf(m[qt] - mn); m[qt] = mn;
            float ps = 0.f; float pv[4][4];
#pragma unroll
            for (int kt = 0; kt < 4; ++kt)
#pragma unroll
                for (int r = 0; r < 4; ++r) { pv[kt][r] = __expf(S[kt][qt][r] - mn); ps += pv[kt][r]; }
            l[qt] = l[qt] * al + ps;
#pragma unroll
            for (int i = 0; i < 4; ++i) O[i][qt] *= al;
#pragma unroll
            for (int ksx = 0; ksx < 2; ++ksx) { u32x4 pk; pk.x = pack2bf(pv[2 * ksx][0], pv[2 * ksx][1]); pk.y = pack2bf(pv[2 * ksx][2], pv[2 * ksx][3]);
                pk.z = pack2bf(pv[2 * ksx + 1][0], pv[2 * ksx + 1][1]); pk.w = pack2bf(pv[2 * ksx + 1][2], pv[2 * ksx + 1][3]); pf[qt][ksx] = __builtin_bit_cast(bf16x8, pk); }
        }
#pragma unroll
        for (int dvt = 0; dvt < 4; ++dvt)
#pragma unroll
            for (int ksx = 0; ksx < 2; ++ksx) {
                const int q4 = (lane & 15) >> 2, p4 = lane & 3;
                const char* a0 = vs + (32 * ksx + 4 * g + q4) * AT_ROWB + (16 * dvt + 4 * p4) * 2;
                const s16x4 v0 = __builtin_amdgcn_ds_read_tr16_b64_v4i16((__attribute__((address_space(3))) s16x4*)(a0));
                const s16x4 v1 = __builtin_amdgcn_ds_read_tr16_b64_v4i16((__attribute__((address_space(3))) s16x4*)(a0 + 16 * AT_ROWB));
                bf16x8 va; va[0] = v0[0]; va[1] = v0[1]; va[2] = v0[2]; va[3] = v0[3]; va[4] = v1[0]; va[5] = v1[1]; va[6] = v1[2]; va[7] = v1[3];
#pragma unroll
                for (int qt = 0; qt < 2; ++qt) O[dvt][qt] = __builtin_amdgcn_mfma_f32_16x16x32_bf16(va, pf[qt][ksx], O[dvt][qt], 0, 0, 0);
            }
        }
        if (ti + 1 < u.ntiles) attn_write(p, u, kp0n, tid, rk, rv, stg + ((ti + 1) & 1) * AT_STAGE);
        kp0 = kp0n;
        __syncthreads();
    }
#pragma unroll
    for (int qt = 0; qt < 2; ++qt) {
        float lt = l[qt]; lt += shfl_xor_f(lt, 16); lt += shfl_xor_f(lt, 32);
        if (u.has_sink) lt += __expf(u.sink - m[qt]);
        const float inv = 1.0f / lt; const int qi = 32 * w + 16 * qt + c; bf16_t* yr = p.Y + (size_t)(u.qrow0 + qi) * 512 + u.ycol;
#pragma unroll
        for (int dvt = 0; dvt < 4; ++dvt) { uint2 o; o.x = pack2bf(O[dvt][qt][0] * inv, O[dvt][qt][1] * inv); o.y = pack2bf(O[dvt][qt][2] * inv, O[dvt][qt][3] * inv); *(uint2*)(yr + 16 * dvt + 4 * g) = o; }
    }
}
constexpr int N_HG = BATCH * 8, N_UB = BATCH * 4 * (ROWS / 2), N_UA = BATCH * 4 * (SEQ / 128), N_UC = BATCH * 8 * (CTXL / 128);
DEV void attn_decode(const Params& p, int layer, int item, AttnUnit& u) {
    u.rope = false; u.has_sink = false; u.sink = 0.f; u.rp = 0; int nloc = 0;
    if (item < N_UB) {
        const int rp = item % (ROWS / 2), h = (item / (ROWS / 2)) % 4, b = item / (ROWS / 2 * 4);
        u.type = 1; u.b = b; u.h = h; u.qrow0 = b * TPB + CTXL + rp * 128; u.qpos0 = rp * 128;
        u.qcol = C_BQ + h * 64; u.kcol = C_BK + h * 64; u.vcol = C_BV + h * 64; u.ycol = 256 + h * 64;
        const int r0 = clampi(2 * rp - 4, 0, ROWS - 8), r1 = clampi(2 * rp + 1 - 4, 0, ROWS - 8) + 7;
        nloc = r1 - r0 + 1; u.rp = r0 * 64 - u.qpos0;
    } else if (item < N_UB + N_UA) {
        const int it = item - N_UB; const int blk = it % (SEQ / 128), h = (it / (SEQ / 128)) % 4, b = it / (SEQ / 128 * 4);
        u.type = 0; u.b = b; u.h = h; u.qrow0 = b * TPB + CTXL + blk * 128; u.qpos0 = blk * 128; u.rope = true;
        u.qcol = C_AQ + h * 64; u.kcol = C_AK + (h >> 1) * 64; u.vcol = C_AV + (h >> 1) * 64; u.ycol = h * 64; u.has_sink = true; u.sink = p.attn_sink[layer * 4 + h];
        const int k0 = (blk * 128 - 128 < 0) ? 0 : blk * 128 - 128, k1 = (blk * 128 + 256 > SEQ) ? SEQ : blk * 128 + 256;
        nloc = (k1 - k0) / 64; u.rp = k0 - u.qpos0;
    } else {
        const int it = item - N_UB - N_UA; const int qb = it % (CTXL / 128), h = (it / (CTXL / 128)) % 4, wh = (it / (CTXL / 128 * 4)) % 2, b = it / (CTXL / 128 * 8);
        u.type = 2; u.b = b; u.h = h; u.qrow0 = b * TPB + qb * 128; u.qpos0 = 0;
        if (wh) { u.qcol = C_BQ + h * 64; u.kcol = C_BK + h * 64; u.vcol = C_BV + h * 64; u.ycol = 256 + h * 64; }
        else { u.qcol = C_AQ + h * 64; u.kcol = C_AK + (h >> 1) * 64; u.vcol = C_AV + (h >> 1) * 64; u.ycol = h * 64; u.has_sink = true; u.sink = p.attn_sink[layer * 4 + h]; }
    }
    u.ntiles = nloc + CTXL / 64;
}
constexpr float U8_SCALE = 512.0f, V8_SCALE = 64.0f;
DEV unsigned pk4_fp8(float a, float b, float c, float d, float sc) {
    a = fminf(fmaxf(a * sc, -448.f), 448.f); b = fminf(fmaxf(b * sc, -448.f), 448.f); c = fminf(fmaxf(c * sc, -448.f), 448.f); d = fminf(fmaxf(d * sc, -448.f), 448.f);
    int r = __builtin_amdgcn_cvt_pk_fp8_f32(a, b, 0, false); r = __builtin_amdgcn_cvt_pk_fp8_f32(c, d, r, true); return (unsigned)r;
}
constexpr float U4_SCALE = 64.0f, V4_SCALE = 5.657f;
DEV unsigned pk8_fp4(const float4& a, const float4& b, float sc) {
    const float v[8] = {a.x, a.y, a.z, a.w, b.x, b.y, b.z, b.w}; unsigned r = 0u; float c[8];
#pragma unroll
    for (int j = 0; j < 8; ++j) c[j] = fminf(fmaxf(v[j] * sc, -6.f), 6.f);
    r = __builtin_amdgcn_cvt_scalef32_pk_fp4_f32(r, c[0], c[1], 1.0f, 0); r = __builtin_amdgcn_cvt_scalef32_pk_fp4_f32(r, c[2], c[3], 1.0f, 1);
    r = __builtin_amdgcn_cvt_scalef32_pk_fp4_f32(r, c[4], c[5], 1.0f, 2); r = __builtin_amdgcn_cvt_scalef32_pk_fp4_f32(r, c[6], c[7], 1.0f, 3);
    return r;
}
DEV void unpack16_fp4(const uint2& r, float* x) {
    const unsigned w[2] = {r.x, r.y};
#pragma unroll
    for (int q = 0; q < 2; ++q) {
        const f32x2 a = __builtin_amdgcn_cvt_scalef32_pk_f32_fp4(w[q], 1.0f, 0), b = __builtin_amdgcn_cvt_scalef32_pk_f32_fp4(w[q], 1.0f, 1),
                    c = __builtin_amdgcn_cvt_scalef32_pk_f32_fp4(w[q], 1.0f, 2), d = __builtin_amdgcn_cvt_scalef32_pk_f32_fp4(w[q], 1.0f, 3);
        x[8 * q] = a.x; x[8 * q + 1] = a.y; x[8 * q + 2] = b.x; x[8 * q + 3] = b.y; x[8 * q + 4] = c.x; x[8 * q + 5] = c.y; x[8 * q + 6] = d.x; x[8 * q + 7] = d.y; }
}
constexpr int N_UV = 256;
DEV void uvconv8_chunk(const Params& p, int layer, int chunk) {
    const int tid = otid();
    const float4* u = (const float4*)(p.peer_u + (size_t)layer * NEXP * DM); const float4* v = (const float4*)(p.peer_v + (size_t)layer * NEXP * DM);
    constexpr long PER = (long)NEXP * DM / 16 / N_UV;
    for (long i = (long)chunk * PER + tid; i < (long)(chunk + 1) * PER; i += 256) {
        uint2 a, b;
        { const float4 x0 = u[4 * i], x1 = u[4 * i + 1], x2 = u[4 * i + 2], x3 = u[4 * i + 3]; a.x = pk8_fp4(x0, x1, U4_SCALE); a.y = pk8_fp4(x2, x3, U4_SCALE); }
        { const float4 x0 = v[4 * i], x1 = v[4 * i + 1], x2 = v[4 * i + 2], x3 = v[4 * i + 3]; b.x = pk8_fp4(x0, x1, V4_SCALE); b.y = pk8_fp4(x2, x3, V4_SCALE); }
        ((uint2*)p.U8)[i] = a; ((uint2*)p.V8)[i] = b;
    }
}
DEV void st_mixers(const Params& p, int layer, char* smem, int* ticket) {
    const int natt = N_UB + N_UA + (layer == 0 ? N_UC : 0);
    const int total = N_HG + natt + N_UV;
    int* slot = (int*)(smem + 65536 + 32);
    for (;;) {
        __syncthreads();
        if (threadIdx.x == 0) *slot = atomicAdd(ticket, 1);
        __syncthreads();
        const int item = __builtin_amdgcn_readfirstlane(*slot);
        if (item >= total) break;
        if (item < N_HG) st_hgrn_mfma(p, layer, smem, item);
        else if (item < N_HG + natt) { AttnUnit u; attn_decode(p, layer, item - N_HG, u); attn_unit(p, layer, u, smem); }
        else uvconv8_chunk(p, layer, item - N_HG - natt);
    }
}
DEV void unpack16_fp8(const u32x4& r, float* x) {
    const unsigned w[4] = {r.x, r.y, r.z, r.w};
#pragma unroll
    for (int q = 0; q < 4; ++q) { const f32x2 lo = __builtin_amdgcn_cvt_pk_f32_fp8((int)w[q], false), hi = __builtin_amdgcn_cvt_pk_f32_fp8((int)w[q], true); x[4 * q] = lo.x; x[4 * q + 1] = lo.y; x[4 * q + 2] = hi.x; x[4 * q + 3] = hi.y; }
}
typedef int v8i_t __attribute__((ext_vector_type(8)));
typedef int v2i_t __attribute__((ext_vector_type(2)));
constexpr float X4_SCALE = 0.25f;
DEV void st_peer_expert_fused(const Params& p, int layer, bool lat_only, char* smem) {
    const int tid = otid(), lane = tid & 63, w = tid >> 6;
    char* wl = smem + w * 14336;
    int* idxs = (int*)wl; float* gates = (float*)(wl + 1024); unsigned char* xq = (unsigned char*)(wl + 2048); char* Tb = wl + 5120; char* At = wl + 5120 + 8448;
    int* itab = (int*)Tb + (lane & 15) * 32;
    const int ngroups = (lat_only ? NLAT : NTOK) / 8; const bool last = (layer == DEPTH - 1);
    for (int grp = blockIdx.x; grp < ngroups; grp += gridDim.x) {
        if (lane < 16) {
            const int tl = lane >> 3, h = lane & 7; const int r = grp * 8 + w * 2 + tl; const int row = lat_only ? lat_row(r) : r;
            const float* v1 = p.CANDV + ((size_t)row * 16 + h * 2) * 16; const float* v2 = v1 + 16; const int* i1 = p.CANDI + ((size_t)row * 16 + h * 2) * 16; const int* i2 = i1 + 16;
            float a1[16], a2[16];
#pragma unroll
            for (int j = 0; j < 16; ++j) { a1[j] = v1[j]; a2[j] = v2[j]; itab[j] = i1[j]; itab[16 + j] = i2[j]; }
            float V[16];
#pragma unroll
            for (int j = 0; j < 16; ++j) V[j] = -3.0e38f;
            CombKey<0, 0>::run(V, a1, a2);
            float sum = 0.f, e[16];
#pragma unroll
            for (int j = 0; j < 16; ++j) { e[j] = __expf(u2f(f2u(V[j]) & ~0xFFu) - u2f(f2u(V[0]) & ~0xFFu)); sum += e[j]; }
            const float inv = 1.0f / sum;
#pragma unroll
            for (int j = 0; j < 16; ++j) { const unsigned code = f2u(V[j]) & 0xFFu; idxs[tl * 128 + h * 16 + j] = itab[code >> 4] * NKEYS + itab[16 + (code & 15u)]; gates[tl * 128 + h * 16 + j] = e[j] * inv; }
        }
#pragma unroll 1
        for (int tt = 0; tt < 2; ++tt) {
            const int tok = tt; const int r = grp * 8 + w * 2 + tt; const int row = lat_only ? lat_row(r) : r;
            const int dgl = lane & 15, gq = lane >> 4;
            bf16_t* xb16 = p.RB + (size_t)row * DM + 16 * lane;
            const u32x4 rb0 = *(const u32x4*)xb16, rb1 = *(const u32x4*)(xb16 + 8);
            { float rr[16];
              { float hf[16]; const bf16_t* hp = p.H + (size_t)row * DM + 16 * lane; const u32x4 h0 = *(const u32x4*)hp, h1 = *(const u32x4*)(hp + 8); unpack8(h0, hf); unpack8(h1, hf + 8);
#pragma unroll
                for (int k = 0; k < 16; ++k) rr[k] = hf[k] * X4_SCALE; }
#pragma unroll
              for (int lv = 0; lv < 6; ++lv) {
                  unsigned wq[2];
#pragma unroll
                  for (int q = 0; q < 2; ++q) {
                      float cq[8];
#pragma unroll
                      for (int k = 0; k < 8; ++k) cq[k] = fminf(fmaxf(rr[8 * q + k], -6.f), 6.f);
                      unsigned wv = 0u;
                      wv = __builtin_amdgcn_cvt_scalef32_pk_fp4_f32(wv, cq[0], cq[1], 1.0f, 0); wv = __builtin_amdgcn_cvt_scalef32_pk_fp4_f32(wv, cq[2], cq[3], 1.0f, 1);
                      wv = __builtin_amdgcn_cvt_scalef32_pk_fp4_f32(wv, cq[4], cq[5], 1.0f, 2); wv = __builtin_amdgcn_cvt_scalef32_pk_fp4_f32(wv, cq[6], cq[7], 1.0f, 3);
                      wq[q] = wv;
                      if (lv < 5) {
                          const f32x2 b0 = __builtin_amdgcn_cvt_scalef32_pk_f32_fp4(wv, 1.0f, 0), b1 = __builtin_amdgcn_cvt_scalef32_pk_f32_fp4(wv, 1.0f, 1),
                                      b2 = __builtin_amdgcn_cvt_scalef32_pk_f32_fp4(wv, 1.0f, 2), b3 = __builtin_amdgcn_cvt_scalef32_pk_f32_fp4(wv, 1.0f, 3);
                          rr[8 * q] = (rr[8 * q] - b0.x) * 4.f; rr[8 * q + 1] = (rr[8 * q + 1] - b0.y) * 4.f; rr[8 * q + 2] = (rr[8 * q + 2] - b1.x) * 4.f; rr[8 * q + 3] = (rr[8 * q + 3] - b1.y) * 4.f;
                          rr[8 * q + 4] = (rr[8 * q + 4] - b2.x) * 4.f; rr[8 * q + 5] = (rr[8 * q + 5] - b2.y) * 4.f; rr[8 * q + 6] = (rr[8 * q + 6] - b3.x) * 4.f; rr[8 * q + 7] = (rr[8 * q + 7] - b3.y) * 4.f;
                      }
                  }
                  *(uint2*)(xq + 512 * lv + 8 * lane) = (uint2){wq[0], wq[1]};
              }
            }
            const unsigned char* xb = xq + 512 * (dgl < 6 ? dgl : 0) + 16 * gq;
            const float wlev = (dgl < 6) ? __builtin_amdgcn_ldexpf(1.0f, -2 * dgl) : 0.f;
            float accT[16];
#pragma unroll
            for (int n = 0; n < 16; ++n) accT[n] = 0.f;
            const int* idx = idxs + tok * 128; const float* gate = gates + tok * 128;
            uint2 vr[32];
#pragma unroll
            for (int j = 0; j < 32; ++j) { const int id = __builtin_amdgcn_readfirstlane(idx[j]); vr[j] = *(const uint2*)(p.V8 + (size_t)id * (DM / 2) + 8 * lane); }
#pragma unroll 1
            for (int e0 = 0; e0 < PE; e0 += 32) {
                float avg[2];
#pragma unroll
                for (int hg = 0; hg < 2; ++hg) {
                    const unsigned char* urow = p.U8 + (size_t)idx[e0 + 16 * hg + dgl] * (DM / 2) + 16 * gq;
                    f32x4 dd = (f32x4){0.f, 0.f, 0.f, 0.f};
#pragma unroll
                    for (int mh = 0; mh < 2; ++mh) {
                        u32x4 ua[4];
#pragma unroll
                        for (int m = 0; m < 4; ++m) ua[m] = *(const u32x4*)(urow + 64 * (4 * mh + m));
#pragma unroll
                        for (int m = 0; m < 4; ++m)
                          { const u32x4 bq = *(const u32x4*)(xb + 64 * (4 * mh + m));
                            dd = __builtin_amdgcn_mfma_scale_f32_16x16x128_f8f6f4((v8i_t){(int)ua[m].x, (int)ua[m].y, (int)ua[m].z, (int)ua[m].w, 0, 0, 0, 0},
                                     (v8i_t){(int)bq.x, (int)bq.y, (int)bq.z, (int)bq.w, 0, 0, 0, 0}, dd, 4, 4, 0, 0x7f7f7f7f, 0, 0x7f7f7f7f); }
                    }
                    float t;
                    { float s4[4];
#pragma unroll
                      for (int r = 0; r < 4; ++r) s4[r] = row16_sum(dd[r] * wlev);
                      const int src = 16 * (dgl >> 2);
                      const float t0 = __shfl(s4[0], src, 64), t1 = __shfl(s4[1], src, 64), t2 = __shfl(s4[2], src, 64), t3 = __shfl(s4[3], src, 64);
                      t = (dgl & 2) ? ((dgl & 1) ? t3 : t2) : ((dgl & 1) ? t1 : t0); }
                    avg[hg] = gate[e0 + 16 * hg + dgl] * gelu_tanh_(t * (1.0f / (U4_SCALE * X4_SCALE))) * (1.0f / V4_SCALE);
                }
                int sca; v8i_t aop;
                { const float avs = (gq & 1) ? avg[1] : avg[0];
                  float am = fabsf(avs); am = fmaxf(am, dppf<0x128>(am)); am = fmaxf(am, dppf<0x124>(am)); am = fmaxf(am, dppf<0x122>(am)); am = fmaxf(am, dppf<0x121>(am));
                  int es = (int)((f2u(am) >> 23) & 0xffu) - 127; es = es < -100 ? -100 : es;
                  float r = avs * __builtin_amdgcn_ldexpf(1.0f, 1 - es);
                  unsigned word = 0u;
#pragma unroll
                  for (int lv = 0; lv < 4; ++lv) {
                      const float cq = fminf(fmaxf(r, -6.f), 6.f);
                      const unsigned wv = __builtin_amdgcn_cvt_scalef32_pk_fp4_f32(0u, cq, cq, 1.0f, 0);
                      word |= (wv & 0xFu) << (4 * lv);
                      const f32x2 bk = __builtin_amdgcn_cvt_scalef32_pk_f32_fp4(wv, 1.0f, 0);
                      r = (r - bk.x) * 4.f; }
                  const unsigned rep = (gq < 2) ? word * 0x00010001u : 0u;
                  *(uint2*)(At + gq * 128 + dgl * 8) = (uint2){rep, rep};
                  sca = 127 + es - 1 - 2 * (dgl & 3); sca = sca < 0 ? 0 : (sca > 254 ? 254 : sca);
                  const v2i_t t2 = __builtin_amdgcn_ds_read_tr4_b64_v2i32((LAS v2i_t*)(At + gq * 128 + dgl * 8)); aop = (v8i_t){t2.x, t2.y, 0, 0, 0, 0, 0, 0}; }
                const char* trow = Tb + (dgl + 16 * (gq & 1)) * 264;
#pragma unroll
                for (int hf2 = 0; hf2 < 2; ++hf2) {
                    if ((lane >> 5) == hf2) {
#pragma unroll
                        for (int j = 0; j < 32; ++j) *(uint2*)(Tb + j * 264 + 8 * (lane & 31)) = vr[j];
                    }
                    if (hf2 == 1 && e0 + 32 < PE) {
#pragma unroll
                        for (int j = 0; j < 32; ++j) { const int id = __builtin_amdgcn_readfirstlane(idx[e0 + 32 + j]); vr[j] = *(const uint2*)(p.V8 + (size_t)id * (DM / 2) + 8 * lane); }
                    }
                    v2i_t tb[2][4];
#pragma unroll
                    for (int gg = 0; gg < 4; ++gg) tb[0][gg] = __builtin_amdgcn_ds_read_tr4_b64_v2i32((LAS v2i_t*)(trow + 8 * gg));
#pragma unroll
                    for (int m = 0; m < 8; ++m) {
                        if (m + 1 < 8) {
#pragma unroll
                            for (int gg = 0; gg < 4; ++gg) tb[(m + 1) & 1][gg] = __builtin_amdgcn_ds_read_tr4_b64_v2i32((LAS v2i_t*)(trow + 8 * (4 * (m + 1) + gg)));
                        }
                        f32x4 d4[4];
#pragma unroll
                        for (int gg = 0; gg < 4; ++gg)
                            d4[gg] = __builtin_amdgcn_mfma_scale_f32_16x16x128_f8f6f4(aop, __builtin_shufflevector(tb[m & 1][gg], tb[m & 1][gg], 0, 1, -1, -1, -1, -1, -1, -1), (f32x4){0.f, 0.f, 0.f, 0.f}, 4, 4, 0, sca, 0, 0x7f7f7f7f);
                        float sm4[4];
#pragma unroll
                        for (int gg = 0; gg < 4; ++gg) sm4[gg] = (d4[gg][0] + d4[gg][1]) + (d4[gg][2] + d4[gg][3]);
                        accT[8 * hf2 + m] += (gq & 2) ? ((gq & 1) ? sm4[3] : sm4[2]) : ((gq & 1) ? sm4[1] : sm4[0]);
                    }
                }
            }
            float acc[16];
            { float* tf = (float*)Tb;
#pragma unroll
              for (int n = 0; n < 16; ++n) tf[512 * (n >> 3) + 16 * (4 * (n & 7) + gq) + dgl] = accT[n];
#pragma unroll
              for (int q = 0; q < 4; ++q) { const float4 t4 = *(const float4*)(tf + 16 * lane + 4 * q); acc[4 * q] = t4.x; acc[4 * q + 1] = t4.y; acc[4 * q + 2] = t4.z; acc[4 * q + 3] = t4.w; } }
            const float* g2 = mod_row(p, layer, row) + 5 * DM + 16 * lane;
            float xn[16]; float ss = 0.f;
            { float xv[16]; unpack8(rb0, xv); unpack8(rb1, xv + 8);
#pragma unroll
              for (int q = 0; q < 4; ++q) { const float4 gg = *(const float4*)(g2 + 4 * q);
                  xn[4 * q] = xv[4 * q] + gg.x * acc[4 * q]; xn[4 * q + 1] = xv[4 * q + 1] + gg.y * acc[4 * q + 1]; xn[4 * q + 2] = xv[4 * q + 2] + gg.z * acc[4 * q + 2]; xn[4 * q + 3] = xv[4 * q + 3] + gg.w * acc[4 * q + 3]; } }
#pragma unroll
            for (int k = 0; k < 16; ++k) ss += xn[k] * xn[k];
            ss = wave_sum(ss); const float rs = 1.0f / sqrtf(ss * (1.0f / DM) + EPS);
            if (last) {
                const float* fn = p.final_norm + 16 * lane; float* xr = resid_out(p, row) + 16 * lane;
                float4 fnv[4];
#pragma unroll
                for (int q = 0; q < 4; ++q) fnv[q] = *(const float4*)(fn + 4 * q);
#pragma unroll
                for (int q = 0; q < 4; ++q) { const float4 gg = fnv[q]; *(float4*)(xr + 4 * q) = (float4){xn[4 * q] * rs * gg.x, xn[4 * q + 1] * rs * gg.y, xn[4 * q + 2] * rs * gg.z, xn[4 * q + 3] * rs * gg.w}; }
            } else {
                const float* m = mod_row(p, layer + 1, row); const float* g = p.norm_mix + (size_t)(layer + 1) * DM + 16 * lane; const float* sh = m + 16 * lane; const float* sc = m + DM + 16 * lane;
                float4 ggv[4], s1v[4], s0v[4];
#pragma unroll
                for (int q = 0; q < 4; ++q) { ggv[q] = *(const float4*)(g + 4 * q); s1v[q] = *(const float4*)(sc + 4 * q); s0v[q] = *(const float4*)(sh + 4 * q); }
                *(u32x4*)xb16 = (u32x4){pack2bf(xn[0], xn[1]), pack2bf(xn[2], xn[3]), pack2bf(xn[4], xn[5]), pack2bf(xn[6], xn[7])};
                *(u32x4*)(xb16 + 8) = (u32x4){pack2bf(xn[8], xn[9]), pack2bf(xn[10], xn[11]), pack2bf(xn[12], xn[13]), pack2bf(xn[14], xn[15])};
                unsigned o[8];
#pragma unroll
                for (int q = 0; q < 4; ++q) { const float4 gg = ggv[q], s1 = s1v[q], s0 = s0v[q];
                    o[2 * q] = pack2bf(xn[4 * q] * rs * gg.x * (1.0f + s1.x) + s0.x, xn[4 * q + 1] * rs * gg.y * (1.0f + s1.y) + s0.y);
                    o[2 * q + 1] = pack2bf(xn[4 * q + 2] * rs * gg.z * (1.0f + s1.z) + s0.z, xn[4 * q + 3] * rs * gg.w * (1.0f + s1.w) + s0.w); }
                bf16_t* hp = p.H + (size_t)row * DM + 16 * lane;
                *(u32x4*)hp = (u32x4){o[0], o[1], o[2], o[3]}; *(u32x4*)(hp + 8) = (u32x4){o[4], o[5], o[6], o[7]};
            }
        }
    }
}
#define XB_TMO      128
#define XB_XCNT(j)  (256  + 64 * (j))
#define XB_XSUB(j)  (1280 + 64 * (j))
#define XB_XGEN(j)  (2304 + 64 * (j))
#define XB_TOP      3328
#define XB_TOPGEN   3392
#define XCD_BAR_WORDS 3456
#define XB_SPIN_CAP (1u << 18)

__device__ __forceinline__ unsigned xb_ld(unsigned* p)              { return __hip_atomic_load(p, __ATOMIC_RELAXED, __HIP_MEMORY_SCOPE_AGENT); }
__device__ __forceinline__ unsigned xb_add(unsigned* p, unsigned v) { return __hip_atomic_fetch_add(p, v, __ATOMIC_RELAXED, __HIP_MEMORY_SCOPE_AGENT); }
__device__ __forceinline__ unsigned xb_xcc_id() { return (unsigned)__builtin_amdgcn_s_getreg((3 << 11) | 20) & 0xFu; }
#define XB_SPIN(cond, bar) do { unsigned _sp = 0; while (cond) { __builtin_amdgcn_s_sleep(1); \
    if ((++_sp & 255u) == 0u) { if (xb_ld(&(bar)[XB_TMO])) break; if (_sp > XB_SPIN_CAP) { atomicAdd(&(bar)[XB_TMO], 1u); break; } } } } while (0)

struct XcdBarrier {
    unsigned* bar; unsigned x;
    volatile LAS unsigned* st;
};

__device__ __forceinline__ XcdBarrier xcd_barrier_post(unsigned* bar, volatile LAS unsigned* st) {
    XcdBarrier b; b.bar = bar; b.x = xb_xcc_id(); b.st = st;
    if (threadIdx.x == 0) (void)xb_add(&bar[XB_XCNT(b.x)], 1u);
    return b;
}
__device__ __forceinline__ void xcd_barrier_complete(unsigned* bar, unsigned x, unsigned& nloc, unsigned& nx) {
    const unsigned G = gridDim.x * gridDim.y * gridDim.z;
    unsigned sum, cnt, mine, sp = 0u;
    for (;;) {
        sum = 0u; cnt = 0u; mine = 0u;
#pragma unroll
        for (unsigned j = 0; j < 16; ++j) { const unsigned c = xb_ld(&bar[XB_XCNT(j)]); sum += c; cnt += (c > 0u) ? 1u : 0u; mine = (j == x) ? c : mine; }
        if (sum == G) break;
        __builtin_amdgcn_s_sleep(1);
        if ((++sp & 255u) == 0u) { if (xb_ld(&bar[XB_TMO])) break; if (sp > XB_SPIN_CAP) { atomicAdd(&bar[XB_TMO], 1u); break; } }
    }
    nloc = mine > 0u ? mine : 1u; nx = cnt > 0u ? cnt : 1u;
}

__device__ __forceinline__ void xcd_barrier(const XcdBarrier& b) {
    asm volatile("s_waitcnt vmcnt(0)" ::: "memory");
    __syncthreads();
    if (threadIdx.x == 0) {
        unsigned* bar = b.bar;
        __builtin_amdgcn_s_waitcnt(0);
        unsigned nloc = b.st[0], nx = b.st[1];
        if (nloc == 0u) { xcd_barrier_complete(bar, b.x, nloc, nx); b.st[0] = nloc; b.st[1] = nx; }
        const unsigned old = xb_add(&bar[XB_XSUB(b.x)], 1u);
        const unsigned gen = old / nloc;
        if (old + 1u == (gen + 1u) * nloc) {
            __builtin_amdgcn_fence(__ATOMIC_RELEASE, "agent");
            asm volatile("s_waitcnt vmcnt(0)" ::: "memory");
            const unsigned og = xb_add(&bar[XB_TOP], 1u);
            const unsigned tg = og / nx;
            if (og + 1u == (tg + 1u) * nx) xb_add(&bar[XB_TOPGEN], 1u);
            else XB_SPIN(xb_ld(&bar[XB_TOPGEN]) == tg, bar);
            __builtin_amdgcn_fence(__ATOMIC_ACQUIRE, "agent");
            xb_add(&bar[XB_XGEN(b.x)], 1u);
            asm volatile("s_waitcnt vmcnt(0)" ::: "memory");
        } else {
            XB_SPIN(xb_ld(&bar[XB_XGEN(b.x)]) == gen, bar);
            __builtin_amdgcn_fence(__ATOMIC_ACQUIRE, "agent");
            asm volatile("s_waitcnt vmcnt(0)" ::: "memory");
        }
    }
    __syncthreads();
}

DEV void st_mod_fast(const Params& p, char* smem) {
    const int tid = otid(), nl = tid & 31, kg = tid >> 5; float* tab = (float*)smem; float* red = (float*)(smem + 36864);
    for (int blk = blockIdx.x; blk < DEPTH * NMODW / 32; blk += gridDim.x) {
        const int l = blk / (NMODW / 32), n = (blk % (NMODW / 32)) * 32 + nl;
        const float* w = p.w_mod + (size_t)l * DM * NMODW + n;
        float acc[17];
#pragma unroll
        for (int r = 0; r < 17; ++r) acc[r] = 0.f;
        for (int kh = 0; kh < 2; ++kh) {
            __syncthreads();
            { float cvv[34];
#pragma unroll
              for (int i = 0; i < 34; ++i) { const int e = tid + 256 * i, r = e >> 9, k = kh * 512 + (e & 511); cvv[i] = (r < 16) ? p.c[(size_t)(r < BATCH ? r : 0) * DM + k] : p.c_ctx[k]; }
#pragma unroll
              for (int i = 0; i < 34; ++i) tab[tid + 256 * i] = siluf_(cvv[i]); }
            __syncthreads();
            const float* wk = w + (size_t)(kh * 512 + kg * 64) * NMODW; const float* tk = tab + kg * 64;
#pragma unroll 2
            for (int k8 = 0; k8 < 64; k8 += 8) {
                float wv[8];
#pragma unroll
                for (int u = 0; u < 8; ++u) wv[u] = wk[(size_t)(k8 + u) * NMODW];
#pragma unroll
                for (int r = 0; r < 17; ++r) { const float4 t0 = *(const float4*)(tk + r * 512 + k8), t1 = *(const float4*)(tk + r * 512 + k8 + 4);
                    acc[r] += t0.x * wv[0] + t0.y * wv[1] + t0.z * wv[2] + t0.w * wv[3] + t1.x * wv[4] + t1.y * wv[5] + t1.z * wv[6] + t1.w * wv[7]; }
            }
        }
#pragma unroll
        for (int r = 0; r < 17; ++r) red[(kg * 17 + r) * 32 + nl] = acc[r];
        __syncthreads();
        for (int e = tid; e < 17 * 32; e += 256) {
            const int r = e >> 5, c = e & 31; float sm = 0.f;
#pragma unroll
            for (int q = 0; q < 8; ++q) sm += red[(q * 17 + r) * 32 + c];
            const int nn = (blk % (NMODW / 32)) * 32 + c;
            p.MOD[((size_t)l * 17 + r) * NMODW + nn] = sm + p.b_mod[(size_t)l * NMODW + nn];
        }
    }
    __syncthreads();
}
DEV void wt_item_load(const Params& p, int item, int tid, float (&v)[16]) {
    constexpr int NT = (INW + DM + PQW) / 64, KT = DM / 64;
    const int l = item / (NT * KT), r = item % (NT * KT), nt = r / KT, kt = r % KT; const int n0 = nt * 64, k0 = kt * 64;
    const float* src; int ld, nn;
    if (n0 < INW) { src = p.w_in + (size_t)l * DM * INW; ld = INW; nn = n0; } else if (n0 < INW + DM) { src = p.w_out + (size_t)l * DM * DM; ld = DM; nn = n0 - INW; } else { src = p.peer_wq + (size_t)l * DM * PQW; ld = PQW; nn = n0 - INW - DM; }
#pragma unroll
    for (int i = 0; i < 16; ++i) { const int e = tid + 256 * i, kk = e >> 6, n = e & 63; v[i] = src[(size_t)(k0 + kk) * ld + nn + n]; }
}
DEV void st_wt_fast(const Params& p, char* smem) {
    const int tid = otid(); float* t = (float*)smem;
    constexpr int NT = (INW + DM + PQW) / 64, KT = DM / 64, NIT = DEPTH * NT * KT;
    float nx[16];
    if ((int)blockIdx.x < NIT) wt_item_load(p, blockIdx.x, tid, nx);
    for (int item = blockIdx.x; item < NIT; item += gridDim.x) {
        const int l = item / (NT * KT), r = item % (NT * KT), nt = r / KT, kt = r % KT; const int n0 = nt * 64, k0 = kt * 64;
        float cur[16];
#pragma unroll
        for (int i = 0; i < 16; ++i) cur[i] = nx[i];
        if (item + (int)gridDim.x < NIT) wt_item_load(p, item + gridDim.x, tid, nx);
        __syncthreads();
#pragma unroll
        for (int i = 0; i < 16; ++i) { const int e = tid + 256 * i, kk = e >> 6, n = e & 63; t[kk * 65 + n] = cur[i]; }
        __syncthreads();
        bf16_t* dst = p.WT + (size_t)l * WTL + (size_t)n0 * DM + k0;
#pragma unroll
        for (int i = 0; i < 8; ++i) { const int e = tid + 256 * i, n = e >> 5, k2 = (e & 31) * 2; *(unsigned*)(dst + (size_t)n * DM + k2) = pack2bf(t[k2 * 65 + n], t[(k2 + 1) * 65 + n]); }
    }
    const long gt = GT, gs = GS;
    for (long i = gt; i < (long)DEPTH * 2 * NKEYS * 128; i += gs) {
        const int l = (int)(i / (2 * NKEYS * 128)); const int e = (int)(i % (2 * NKEYS * 128)); const int hf = e / (NKEYS * 128), r = e % (NKEYS * 128);
        p.KB[i] = f2bf((hf ? p.peer_k2 : p.peer_k1)[(size_t)l * NKEYS * 128 + r]);
    }
    for (long i = gt; i < 64 * 16; i += gs) {
        const int pos = (int)(i / 16), f = (int)(i % 16);
        const float inv = powf(10000.0f, -((float)(2 * f)) / 32.0f); const float ang = (float)pos * inv;
        p.ROPE[i] = cosf(ang); p.ROPE[1024 + i] = sinf(ang);
    }
}

__global__ void __launch_bounds__(256, 2) __attribute__((target("no-packed-fp32-ops"))) mega(Params p) {
    __shared__ __attribute__((aligned(16))) char smem[65536 + 64];
    const long gs = GS; const int bid = blockIdx.x, nb = gridDim.x;
    if (threadIdx.x < 4) ((volatile LAS unsigned*)(smem + 65536))[threadIdx.x] = 0u;
    __syncthreads();
    const XcdBarrier xb = xcd_barrier_post(p.BAR, (volatile LAS unsigned*)(smem + 65536));
    st_mod_fast(p, smem); st_wt_fast(p, smem);
    xcd_barrier(xb);
    st_norm_fast(p, 0, 0, false);
    xcd_barrier(xb);
    for (int l = 0; l < DEPTH; ++l) {
        const bool last = (l == DEPTH - 1);
        st_gemm_mfma(p, l, 0, false, smem, bid, nb);
        xcd_barrier(xb);
        st_mixers(p, l, smem, p.TICKET + l);
        xcd_barrier(xb);
        st_merge_fast(p, l, last);
        xcd_barrier(xb);
        st_gemm_mfma(p, l, 1, last, smem, bid, nb);
        xcd_barrier(xb);
        st_norm_fast(p, l, 1, last);
        xcd_barrier(xb);
        st_gemm_mfma(p, l, 2, last, smem, bid, nb);
        xcd_barrier(xb);
        st_peer_expert_fused(p, l, last, smem);
        if (!last) xcd_barrier(xb);
    }
}

extern "C" void kernel_launch(void* const* d_in, const int* in_sizes, int n_in, void* d_out, int out_size, void* d_ws, size_t ws_size, hipStream_t stream) {
    static int grid_blocks = 0;
    if (!grid_blocks) {
        int dev = 0, cus = 0, per_cu = 0;
        hipGetDevice(&dev);
        hipDeviceGetAttribute(&cus, hipDeviceAttributeMultiprocessorCount, dev);
        hipOccupancyMaxActiveBlocksPerMultiprocessor(&per_cu, mega, 256, 0);
        if (per_cu > 2) per_cu = 2;
        if (per_cu < 1) per_cu = 1;
        grid_blocks = cus * per_cu;
    }
    Params p = make_params(d_in, d_out, d_ws);
    hipMemsetAsync((void*)p.TICKET, 0, 256 + XCD_BAR_WORDS * 4, stream);
    void* args[] = {&p};
    hipError_t e = hipLaunchCooperativeKernel((void*)mega, dim3(grid_blocks), dim3(256), args, 0, stream);
    if (e != hipSuccess) fprintf(stderr, "cooperative launch failed: %s (grid %d)\n", hipGetErrorString(e), grid_blocks);
}
#endif
```

```cpp
#ifndef HOST_EMU
#include <hip/hip_runtime.h>
#include <hip/hip_cooperative_groups.h>
#include <cstdio>
namespace cg = cooperative_groups;
#define DEV __device__ __forceinline__
#else
#include <cmath>
#include <cstring>
#include <cstdint>
#include <cstdio>
#define DEV inline
#define __global__
#define __device__
struct float4 { float x, y, z, w; };
struct ushort4 { unsigned short x, y, z, w; };
#endif
#include <cstddef>
#include <cstring>

#ifndef CFG_BATCH
#define CFG_BATCH 16
#endif
#ifndef CFG_SEQ
#define CFG_SEQ 2048
#endif
#ifndef CFG_CTX
#define CFG_CTX 256
#endif
#ifndef CFG_NKEYS
#define CFG_NKEYS 128
#endif

typedef unsigned short bf16_t;

constexpr int BATCH = CFG_BATCH, SEQ = CFG_SEQ, CTXL = CFG_CTX, DM = 1024, DEPTH = 2;
constexpr int TPB = SEQ + CTXL;
constexpr int NTOK = BATCH * TPB;
constexpr int NLAT = BATCH * SEQ;
constexpr int INW = 3328, NMODW = 6144, GRIDW = 64, ROWS = SEQ / GRIDW;
constexpr int NKEYS = CFG_NKEYS, NEXP = NKEYS * NKEYS, PHEADS = 8, PQW = 2048, PTOPK = 16, PE = PHEADS * PTOPK;
constexpr int WTL = (INW + DM + PQW) * DM;
constexpr int C_AQ = 0, C_AK = 256, C_AV = 384, C_BQ = 512, C_BK = 768, C_BV = 1024, C_CX = 1280, C_CB = 1536, C_CC = 1792,
              C_DQ = 2048, C_DZF = 2304, C_DZB = 2560, C_DI = 2816, C_DG = 3072;
constexpr float EPS = 1e-6f, MASKV = -1e30f;

struct Params {
    const float *x, *c, *ctx, *c_ctx, *w_mod, *b_mod, *norm_mix, *norm_ffn, *w_in, *conv_w, *attn_sink, *na_rpb, *lb_logits,
                *group_norm, *w_out, *peer_wq, *peer_k1, *peer_k2, *peer_u, *peer_v, *final_norm;
    float* out;
    float* MOD;
    float* ROPE;
    int* TICKET;
    bf16_t* WT;
    bf16_t* KB;
    float* CTXR;
    bf16_t* H;
    bf16_t* P;
    bf16_t* Y;
    float* OD;
    bf16_t* ODH;
    bf16_t* RB;
    bf16_t* Q;
    float* CANDV;
    int* CANDI;
    bf16_t* UB;
    bf16_t* VB;
    unsigned char* U8;
    unsigned char* V8;
    unsigned* BAR;
    int* IDX;
    float* GATE;
};

DEV float u2f(unsigned u) { float f; memcpy(&f, &u, 4); return f; }
DEV unsigned f2u(float f) { unsigned u; memcpy(&u, &f, 4); return u; }
DEV bf16_t f2bf(float f) { unsigned u = f2u(f); u += 0x7fffu + ((u >> 16) & 1u); return (bf16_t)(u >> 16); }
DEV float bf2f(bf16_t h) { return u2f(((unsigned)h) << 16); }
DEV float sigmoidf_(float x) { return 1.0f / (1.0f + expf(-x)); }
DEV float siluf_(float x) { return x * sigmoidf_(x); }
DEV float gelu_tanh_(float x) { const float u = 0.7978845608028654f * (x + 0.044715f * x * x * x); const float t = 1.0f - 2.0f / (1.0f + expf(2.0f * u)); return 0.5f * x * (1.0f + t); }
DEV int clampi(int v, int lo, int hi) { return v < lo ? lo : (v > hi ? hi : v); }

DEV const float* resid_in(const Params& p, int layer, int row) {
    const int b = row / TPB, pp = row % TPB;
    if (pp < CTXL) return (layer == 0 ? p.ctx : p.CTXR) + ((size_t)b * CTXL + pp) * DM;
    return (layer == 0 ? p.x : p.out) + ((size_t)b * SEQ + (pp - CTXL)) * DM;
}
DEV float* resid_out(const Params& p, int row) {
    const int b = row / TPB, pp = row % TPB;
    if (pp < CTXL) return p.CTXR + ((size_t)b * CTXL + pp) * DM;
    return p.out + ((size_t)b * SEQ + (pp - CTXL)) * DM;
}
DEV const float* mod_row(const Params& p, int layer, int row) {
    const int b = row / TPB, pp = row % TPB;
    return p.MOD + ((size_t)layer * 17 + (pp < CTXL ? 16 : b)) * NMODW;
}
DEV int lat_row(int i) { return (i / SEQ) * TPB + CTXL + (i % SEQ); }

DEV void st_mod(const Params& p, long gtid, long gsz) {
    for (long i = gtid; i < (long)DEPTH * 17 * NMODW; i += gsz) {
        const int n = (int)(i % NMODW), r = (int)((i / NMODW) % 17), l = (int)(i / ((long)NMODW * 17));
        const float* cv = (r < 16) ? (p.c + (size_t)(r < BATCH ? r : 0) * DM) : p.c_ctx;
        const float* w = p.w_mod + (size_t)l * DM * NMODW + n;
        float acc = 0.f;
        for (int k = 0; k < DM; ++k) acc += siluf_(cv[k]) * w[(size_t)k * NMODW];
        p.MOD[i] = acc + p.b_mod[(size_t)l * NMODW + n];
    }
}
DEV void st_wt(const Params& p, long gtid, long gsz) {
    for (long i = gtid; i < (long)DEPTH * WTL; i += gsz) {
        const int l = (int)(i / WTL); const long e = i % WTL; const int n = (int)(e / DM), k = (int)(e % DM);
        float v;
        if (n < INW) v = p.w_in[((size_t)l * DM + k) * INW + n];
        else if (n < INW + DM) v = p.w_out[((size_t)l * DM + k) * DM + (n - INW)];
        else v = p.peer_wq[((size_t)l * DM + k) * PQW + (n - INW - DM)];
        p.WT[i] = f2bf(v);
    }
    for (long i = gtid; i < (long)DEPTH * 2 * NKEYS * 128; i += gsz) {
        const int l = (int)(i / (2 * NKEYS * 128)); const int e = (int)(i % (2 * NKEYS * 128)); const int hf = e / (NKEYS * 128), r = e % (NKEYS * 128);
        p.KB[i] = f2bf((hf ? p.peer_k2 : p.peer_k1)[(size_t)l * NKEYS * 128 + r]);
    }
    for (long i = gtid; i < 64 * 16; i += gsz) {
        const int pos = (int)(i / 16), f = (int)(i % 16);
        const float inv = powf(10000.0f, -((float)(2 * f)) / 32.0f);
        const float ang = (float)pos * inv;
        p.ROPE[i] = cosf(ang); p.ROPE[1024 + i] = sinf(ang);
    }
}
DEV void st_uvconv(const Params& p, int layer, long gtid, long gsz) {
    const float* u = p.peer_u + (size_t)layer * NEXP * DM; const float* v = p.peer_v + (size_t)layer * NEXP * DM;
    for (long i = gtid; i < (long)NEXP * DM / 4; i += gsz) {
        const float4 a = ((const float4*)u)[i], b = ((const float4*)v)[i];
        ushort4 ua, ub; ua.x = f2bf(a.x); ua.y = f2bf(a.y); ua.z = f2bf(a.z); ua.w = f2bf(a.w); ub.x = f2bf(b.x); ub.y = f2bf(b.y); ub.z = f2bf(b.z); ub.w = f2bf(b.w);
        ((ushort4*)p.UB)[i] = ua; ((ushort4*)p.VB)[i] = ub;
    }
}

DEV void st_norm_naive(const Params& p, int layer, int which, bool lat_only, long gtid, long gsz) {
    const int nrows = lat_only ? NLAT : NTOK;
    for (long i = gtid; i < nrows; i += gsz) {
        const int row = lat_only ? lat_row((int)i) : (int)i;
        const float* xr = resid_in(p, (which == 0) ? layer : 1, row);
        const float* m = mod_row(p, layer, row);
        const float* g = (which ? p.norm_ffn : p.norm_mix) + (size_t)layer * DM;
        const float* sh = m + (which ? 3 : 0) * DM; const float* sc = m + (which ? 4 : 1) * DM;
        float ss = 0.f;
        for (int k = 0; k < DM; ++k) ss += xr[k] * xr[k];
        const float rs = 1.0f / sqrtf(ss * (1.0f / DM) + EPS);
        bf16_t* h = p.H + (size_t)row * DM;
        for (int k = 0; k < DM; ++k) h[k] = f2bf(xr[k] * rs * g[k] * (1.0f + sc[k]) + sh[k]);
    }
}

DEV void gemm_epi(const Params& p, int layer, int mode, int row, int col, float acc) {
    if (mode == 0) p.P[(size_t)row * INW + col] = f2bf(acc);
    else if (mode == 2) p.Q[(size_t)row * PQW + col] = f2bf(acc);
    else { const float g1 = mod_row(p, layer, row)[2 * DM + col]; resid_out(p, row)[col] = resid_in(p, layer, row)[col] + g1 * acc; }
}
DEV void gemm_cfg(const Params& p, int layer, int mode, const bf16_t*& Bt, int& N) {
    const bf16_t* w = p.WT + (size_t)layer * WTL;
    if (mode == 0) { Bt = w; N = INW; } else if (mode == 1) { Bt = w + (size_t)INW * DM; N = DM; } else { Bt = w + (size_t)(INW + DM) * DM; N = PQW; }
}
DEV void st_gemm_naive(const Params& p, int layer, int mode, bool lat_only, long gtid, long gsz) {
    const bf16_t* Bt; int N; gemm_cfg(p, layer, mode, Bt, N);
    const long nrows = lat_only ? NLAT : NTOK;
    for (long i = gtid; i < nrows * N; i += gsz) {
        const int col = (int)(i % N); const int r = (int)(i / N); const int row = lat_only ? lat_row(r) : r;
        const bf16_t* a = p.H + (size_t)row * DM; const bf16_t* b = Bt + (size_t)col * DM;
        float acc = 0.f;
        for (int k = 0; k < DM; ++k) acc += bf2f(a[k]) * bf2f(b[k]);
        gemm_epi(p, layer, mode, row, col, acc);
    }
}

DEV void rope_load(const Params& p, const bf16_t* src, int t, float* dst) {
    const float* cs = p.ROPE; const float* sn = p.ROPE + 1024; const int r = t / GRIDW, c = t % GRIDW;
#pragma unroll
    for (int i = 0; i < 16; ++i) {
        const float x1 = bf2f(src[i]), x2 = bf2f(src[16 + i]); const float cr = cs[r * 16 + i], sr = sn[r * 16 + i];
        dst[i] = x1 * cr - x2 * sr; dst[16 + i] = x1 * sr + x2 * cr;
        const float y1 = bf2f(src[32 + i]), y2 = bf2f(src[48 + i]); const float cc = cs[c * 16 + i], sc = sn[c * 16 + i];
        dst[32 + i] = y1 * cc - y2 * sc; dst[48 + i] = y1 * sc + y2 * cc;
    }
}
DEV float rope_dot(const Params& p, const float* q, const bf16_t* src, int t) {
    const float* cs = p.ROPE; const float* sn = p.ROPE + 1024; const int r = t / GRIDW, c = t % GRIDW; float acc = 0.f;
#pragma unroll
    for (int i = 0; i < 16; ++i) {
        const float x1 = bf2f(src[i]), x2 = bf2f(src[16 + i]); const float cr = cs[r * 16 + i], sr = sn[r * 16 + i];
        acc += q[i] * (x1 * cr - x2 * sr) + q[16 + i] * (x1 * sr + x2 * cr);
        const float y1 = bf2f(src[32 + i]), y2 = bf2f(src[48 + i]); const float cc = cs[c * 16 + i], sc = sn[c * 16 + i];
        acc += q[32 + i] * (y1 * cc - y2 * sc) + q[48 + i] * (y1 * sc + y2 * cc);
    }
    return acc;
}
struct OnlineSm { float m, l; float o[64]; };
DEV void osm_init(OnlineSm& s) { s.m = MASKV; s.l = 0.f;
#pragma unroll
    for (int d = 0; d < 64; ++d) s.o[d] = 0.f; }
DEV void osm_add(OnlineSm& s, float sc, const bf16_t* vrow) {
    const float mn = sc > s.m ? sc : s.m; const float a = expf(s.m - mn), pe = expf(sc - mn);
    s.l = s.l * a + pe; s.m = mn;
#pragma unroll
    for (int d = 0; d < 64; ++d) s.o[d] = s.o[d] * a + pe * bf2f(vrow[d]);
}
DEV void osm_sink(OnlineSm& s, float sk) { const float mn = sk > s.m ? sk : s.m; const float a = expf(s.m - mn);
    s.l = s.l * a + expf(sk - mn); s.m = mn;
#pragma unroll
    for (int d = 0; d < 64; ++d) s.o[d] *= a; }
DEV void osm_store(const OnlineSm& s, bf16_t* dst) { const float inv = 1.0f / s.l;
#pragma unroll
    for (int d = 0; d < 64; ++d) dst[d] = f2bf(s.o[d] * inv); }

DEV void st_attnA_naive(const Params& p, int layer, long gtid, long gsz) {
    for (long i = gtid; i < (long)BATCH * 4 * SEQ; i += gsz) {
        const int t = (int)(i % SEQ), h = (int)((i / SEQ) % 4), b = (int)(i / ((long)SEQ * 4)); const int hk = h >> 1;
        const bf16_t* Pb = p.P + (size_t)b * TPB * INW;
        float q[64]; rope_load(p, Pb + (size_t)(CTXL + t) * INW + C_AQ + h * 64, t, q);
        OnlineSm s; osm_init(s);
        const int k0 = t - 128 < 0 ? 0 : t - 128, k1 = t + 128 > SEQ - 1 ? SEQ - 1 : t + 128;
        for (int kp = k0; kp <= k1; ++kp) {
            const bf16_t* kr = Pb + (size_t)(CTXL + kp) * INW;
            const float sc = rope_dot(p, q, kr + C_AK + hk * 64, kp);
            osm_add(s, sc * 0.125f, kr + C_AV + hk * 64);
        }
        for (int kc = 0; kc < CTXL; ++kc) {
            const bf16_t* kr = Pb + (size_t)kc * INW; float sc = 0.f;
#pragma unroll
            for (int d = 0; d < 64; ++d) sc += q[d] * bf2f(kr[C_AK + hk * 64 + d]);
            osm_add(s, sc * 0.125f, kr + C_AV + hk * 64);
        }
        osm_sink(s, p.attn_sink[layer * 4 + h]);
        osm_store(s, p.Y + ((size_t)b * TPB + CTXL + t) * 512 + h * 64);
    }
}
DEV void st_attnB_naive(const Params& p, int layer, long gtid, long gsz) {
    for (long i = gtid; i < (long)BATCH * 4 * SEQ; i += gsz) {
        const int t = (int)(i % SEQ), h = (int)((i / SEQ) % 4), b = (int)(i / ((long)SEQ * 4));
        const bf16_t* Pb = p.P + (size_t)b * TPB * INW;
        const int r = t / GRIDW, qc = t % GRIDW; const int rs = clampi(r - 4, 0, ROWS - 8), w0 = clampi(qc - 8, 0, GRIDW - 16);
        const float* rpb = p.na_rpb + ((size_t)layer * 4 + h) * 15 * 31;
        float q[64];
#pragma unroll
        for (int d = 0; d < 64; ++d) q[d] = bf2f(Pb[(size_t)(CTXL + t) * INW + C_BQ + h * 64 + d]);
        OnlineSm s; osm_init(s);
        for (int kr_ = rs; kr_ < rs + 8; ++kr_)
            for (int kc = w0; kc < w0 + 16; ++kc) {
                const bf16_t* kr = Pb + (size_t)(CTXL + kr_ * GRIDW + kc) * INW; float sc = 0.f;
#pragma unroll
                for (int d = 0; d < 64; ++d) sc += q[d] * bf2f(kr[C_BK + h * 64 + d]);
                osm_add(s, sc * 0.125f + rpb[(kr_ - r + 7) * 31 + (kc - qc + 15)], kr + C_BV + h * 64);
            }
        for (int kc = 0; kc < CTXL; ++kc) {
            const bf16_t* kr = Pb + (size_t)kc * INW; float sc = 0.f;
#pragma unroll
            for (int d = 0; d < 64; ++d) sc += q[d] * bf2f(kr[C_BK + h * 64 + d]);
            osm_add(s, sc * 0.125f, kr + C_BV + h * 64);
        }
        osm_store(s, p.Y + ((size_t)b * TPB + CTXL + t) * 512 + 256 + h * 64);
    }
}
DEV void st_attnC_naive(const Params& p, int layer, long gtid, long gsz) {
    for (long i = gtid; i < (long)BATCH * 2 * 4 * CTXL; i += gsz) {
        const int tq = (int)(i % CTXL), h = (int)((i / CTXL) % 4), wh = (int)((i / (CTXL * 4)) % 2), b = (int)(i / ((long)CTXL * 8));
        const bf16_t* Pb = p.P + (size_t)b * TPB * INW;
        const int qcol = wh ? C_BQ + h * 64 : C_AQ + h * 64, kcol = wh ? C_BK + h * 64 : C_AK + (h >> 1) * 64, vcol = wh ? C_BV + h * 64 : C_AV + (h >> 1) * 64;
        float q[64];
#pragma unroll
        for (int d = 0; d < 64; ++d) q[d] = bf2f(Pb[(size_t)tq * INW + qcol + d]);
        OnlineSm s; osm_init(s);
        for (int kc = 0; kc < CTXL; ++kc) {
            const bf16_t* kr = Pb + (size_t)kc * INW; float sc = 0.f;
#pragma unroll
            for (int d = 0; d < 64; ++d) sc += q[d] * bf2f(kr[kcol + d]);
            osm_add(s, sc * 0.125f, kr + vcol);
        }
        if (!wh) osm_sink(s, p.attn_sink[layer * 4 + h]);
        osm_store(s, p.Y + ((size_t)b * TPB + tq) * 512 + wh * 256 + h * 64);
    }
}
DEV float hgrn_lb(const Params& p, int layer, int ch) { if (layer == 0) return 0.f; return sigmoidf_(p.lb_logits[256 + ch] - p.lb_logits[ch]); }
DEV void st_hgrn_naive(const Params& p, int layer, long gtid, long gsz) {
    for (long i = gtid; i < (long)BATCH * 4 * 2 * 64; i += gsz) {
        const int v = (int)(i % 64), dir = (int)((i / 64) % 2), h = (int)((i / 128) % 4), b = (int)(i / 512);
        const bf16_t* Pb = p.P + (size_t)b * TPB * INW; const int zc = (dir ? C_DZB : C_DZF) + h * 64;
        float S[64], lb[64];
#pragma unroll
        for (int d = 0; d < 64; ++d) { S[d] = 0.f; lb[d] = hgrn_lb(p, layer, h * 64 + d); }
        float* od = p.OD + ((size_t)dir * NTOK + (size_t)b * TPB) * 256 + h * 64 + v;
        for (int st = 0; st < TPB; ++st) {
            int pp;
            if (st < CTXL) pp = dir ? CTXL - 1 - st : st; else { const int t = st - CTXL; pp = CTXL + (dir ? SEQ - 1 - t : t); }
            const bf16_t* pr = Pb + (size_t)pp * INW; const float vv = bf2f(pr[C_DI + h * 64 + v]); float o = 0.f;
#pragma unroll
            for (int d = 0; d < 64; ++d) {
                const float z = bf2f(pr[zc + d]); const float sg = sigmoidf_(z);
                const float f = lb[d] + (1.0f - lb[d]) * sg, k = (1.0f - lb[d]) * (1.0f - sg);
                S[d] = f * S[d] + k * vv; o += bf2f(pr[C_DQ + h * 64 + d]) * S[d];
            }
            od[(size_t)pp * 256] = o;
        }
    }
}
DEV float mixC_val(const Params& p, int layer, int row, int ch) {
    const int pp = row % TPB; const bool isctx = pp < CTXL; const int lo = isctx ? 0 : CTXL, hi = isctx ? CTXL - 1 : TPB - 1;
    const bf16_t* pr = p.P + (size_t)row * INW; const float* w = p.conv_w + (size_t)layer * 3 * 256;
    float acc = 0.f;
#pragma unroll
    for (int j = 0; j < 3; ++j) { const int q = pp + j - 1; if (q >= lo && q <= hi) { const bf16_t* nr = pr + (ptrdiff_t)(j - 1) * INW; acc += w[j * 256 + ch] * bf2f(nr[C_CC + ch]) * bf2f(nr[C_CX + ch]); } }
    return bf2f(pr[C_CB + ch]) * acc;
}
DEV float mixD_val(const Params& p, int row, int ch) {
    const float o = p.OD[(size_t)row * 256 + ch] + p.OD[((size_t)NTOK + row) * 256 + ch];
    return o * siluf_(bf2f(p.P[(size_t)row * INW + C_DG + ch]));
}
DEV void st_merge_naive(const Params& p, int layer, bool lat_only, long gtid, long gsz) {
    const long nrows = lat_only ? NLAT : NTOK;
    for (long i = gtid; i < nrows * 4; i += gsz) {
        const int g = (int)(i % 4); const int r = (int)(i / 4); const int row = lat_only ? lat_row(r) : r;
        float ss = 0.f;
        for (int ch = 0; ch < 256; ++ch) { const float y = g < 2 ? bf2f(p.Y[(size_t)row * 512 + g * 256 + ch]) : (g == 2 ? mixC_val(p, layer, row, ch) : mixD_val(p, row, ch)); ss += y * y; }
        const float rs = 1.0f / sqrtf(ss * (1.0f / 256.0f) + EPS); const float* gn = p.group_norm + (size_t)layer * DM + g * 256;
        for (int ch = 0; ch < 256; ++ch) { const float y = g < 2 ? bf2f(p.Y[(size_t)row * 512 + g * 256 + ch]) : (g == 2 ? mixC_val(p, layer, row, ch) : mixD_val(p, row, ch));
            p.H[(size_t)row * DM + g * 256 + ch] = f2bf(y * rs * gn[ch]); }
    }
}

#define TOPK_INS(V, I, xv, xi) { float x_ = (xv); int j_ = (xi); _Pragma("unroll") for (int q_ = 0; q_ < 16; ++q_) { if (x_ > V[q_]) { const float tv_ = V[q_]; const int ti_ = I[q_]; V[q_] = x_; I[q_] = j_; x_ = tv_; j_ = ti_; } } }
DEV void st_peer_scores_naive(const Params& p, int layer, bool lat_only, long gtid, long gsz) {
    const long nrows = lat_only ? NLAT : NTOK;
    for (long i = gtid; i < nrows * 16; i += gsz) {
        const int hh = (int)(i % 16); const int r = (int)(i / 16); const int row = lat_only ? lat_row(r) : r; const int hf = hh & 1;
        const bf16_t* q = p.Q + (size_t)row * PQW + hh * 128; const bf16_t* kb = p.KB + ((size_t)layer * 2 + hf) * NKEYS * 128;
        float V[16]; int I[16];
#pragma unroll
        for (int j = 0; j < 16; ++j) { V[j] = -3.0e38f; I[j] = 0; }
        for (int k = 0; k < NKEYS; ++k) { float s = 0.f; for (int d = 0; d < 128; ++d) s += bf2f(q[d]) * bf2f(kb[(size_t)k * 128 + d]); TOPK_INS(V, I, s, k); }
#pragma unroll
        for (int j = 0; j < 16; ++j) { p.CANDV[((size_t)row * 16 + hh) * 16 + j] = V[j]; p.CANDI[((size_t)row * 16 + hh) * 16 + j] = I[j]; }
    }
}
template <int A, int B> struct CombKey {
    static DEV void run(float (&V)[16], const float (&a1)[16], const float (&a2)[16]) {
        if constexpr ((A + 1) * (B + 1) <= 16) {
            float x = u2f((f2u(a1[A] + a2[B]) & ~0xFFu) | (unsigned)(A * 16 + B));
#pragma unroll
            for (int q = 0; q < 16; ++q) { const float hi = fmaxf(V[q], x), lo = fminf(V[q], x); V[q] = hi; x = lo; }
            CombKey<A, B + 1>::run(V, a1, a2); }
        else if constexpr (A < 15) CombKey<A + 1, 0>::run(V, a1, a2);
    }
};
template <int A, int B> struct CombStep {
    static DEV void run(float (&V)[16], int (&I)[16], const float (&a1)[16], const float (&a2)[16], const int (&b1)[16], const int (&b2)[16]) {
        if constexpr ((A + 1) * (B + 1) <= 16) { TOPK_INS(V, I, a1[A] + a2[B], b1[A] * NKEYS + b2[B]); CombStep<A, B + 1>::run(V, I, a1, a2, b1, b2); }
        else if constexpr (A < 15) CombStep<A + 1, 0>::run(V, I, a1, a2, b1, b2);
    }
};
DEV void st_peer_combine(const Params& p, bool lat_only, long gtid, long gsz) {
    const long nrows = lat_only ? NLAT : NTOK;
    for (long i = gtid; i < nrows * 8; i += gsz) {
        const int h = (int)(i % 8); const int r = (int)(i / 8); const int row = lat_only ? lat_row(r) : r;
        const float* v1 = p.CANDV + ((size_t)row * 16 + h * 2) * 16; const float* v2 = v1 + 16; const int* i1 = p.CANDI + ((size_t)row * 16 + h * 2) * 16; const int* i2 = i1 + 16;
        float a1[16], a2[16]; int b1[16], b2[16];
#pragma unroll
        for (int j = 0; j < 16; ++j) { a1[j] = v1[j]; a2[j] = v2[j]; b1[j] = i1[j]; b2[j] = i2[j]; }
        float V[16]; int I[16];
#pragma unroll
        for (int j = 0; j < 16; ++j) { V[j] = -3.0e38f; I[j] = 0; }
        CombStep<0, 0>::run(V, I, a1, a2, b1, b2);
        float sum = 0.f, e[16];
#pragma unroll
        for (int j = 0; j < 16; ++j) { e[j] = expf(V[j] - V[0]); sum += e[j]; }
        const float inv = 1.0f / sum;
#pragma unroll
        for (int j = 0; j < 16; ++j) { p.IDX[(size_t)row * PE + h * 16 + j] = I[j]; p.GATE[(size_t)row * PE + h * 16 + j] = e[j] * inv; }
    }
}
DEV void st_peer_act_naive(const Params& p, bool lat_only, long gtid, long gsz) {
    const long nrows = lat_only ? NLAT : NTOK;
    for (long i = gtid; i < nrows * PE; i += gsz) {
        const int e = (int)(i % PE); const int r = (int)(i / PE); const int row = lat_only ? lat_row(r) : r;
        const bf16_t* h = p.H + (size_t)row * DM; const bf16_t* u = p.UB + (size_t)p.IDX[(size_t)row * PE + e] * DM;
        float s = 0.f;
        for (int k = 0; k < DM; ++k) s += bf2f(h[k]) * bf2f(u[k]);
        p.GATE[(size_t)row * PE + e] *= gelu_tanh_(s);
    }
}
DEV void st_peer_out_naive(const Params& p, int layer, bool lat_only, long gtid, long gsz) {
    const long nrows = lat_only ? NLAT : NTOK;
    for (long i = gtid; i < nrows * DM; i += gsz) {
        const int col = (int)(i % DM); const int r = (int)(i / DM); const int row = lat_only ? lat_row(r) : r;
        const int* idx = p.IDX + (size_t)row * PE; const float* act = p.GATE + (size_t)row * PE;
        float acc = 0.f;
        for (int e = 0; e < PE; ++e) acc += act[e] * bf2f(p.VB[(size_t)idx[e] * DM + col]);
        float* xr = resid_out(p, row); xr[col] += mod_row(p, layer, row)[5 * DM + col] * acc;
    }
}
DEV void st_final_naive(const Params& p, long gtid, long gsz) {
    for (long i = gtid; i < NLAT; i += gsz) {
        float* xr = p.out + (size_t)i * DM; float ss = 0.f;
        for (int k = 0; k < DM; ++k) ss += xr[k] * xr[k];
        const float rs = 1.0f / sqrtf(ss * (1.0f / DM) + EPS);
        for (int k = 0; k < DM; ++k) xr[k] = xr[k] * rs * p.final_norm[k];
    }
}

struct WsMap { size_t u8, mod, rope, ticket, wt, kb, ctxr, h, pp, y, od, rb, q, candv, candi, ub, vb, idx, gate, total; };
inline size_t al256(size_t x) { return (x + 255) & ~(size_t)255; }
inline WsMap ws_map() {
    WsMap m; size_t o = 0;
    m.mod = o; o = al256(o + (size_t)DEPTH * 17 * NMODW * 4);
    m.rope = o; o = al256(o + 2048 * 4);
    m.ticket = o; o = al256(o + 256 + 3456 * 4);
    m.wt = o; o = al256(o + (size_t)DEPTH * WTL * 2);
    m.kb = o; o = al256(o + (size_t)DEPTH * 2 * NKEYS * 128 * 2);
#ifdef HOST_EMU
    m.ctxr = o; o = al256(o + (size_t)BATCH * CTXL * DM * 4);
#else
    m.ctxr = o;
#endif
    m.h = o; o = al256(o + (size_t)NTOK * DM * 2);
    m.pp = o; o = al256(o + (size_t)NTOK * INW * 2);
    m.y = o; o = al256(o + (size_t)NTOK * 512 * 2);
#ifdef HOST_EMU
    m.od = o; o = al256(o + (size_t)2 * NTOK * 256 * 4);
    m.u8 = o; o = al256(o + (size_t)2 * NEXP * DM);
#else
    m.od = o; o = al256(o + (size_t)2 * NTOK * 256 * 2);
    m.u8 = o; o = al256(o + (size_t)NEXP * DM);
#endif
    m.rb = o; o = al256(o + (size_t)NTOK * DM * 2);
    m.total = o;
    m.q = m.pp; m.candv = al256(m.q + (size_t)NTOK * PQW * 2); m.candi = al256(m.candv + (size_t)NTOK * 256 * 4);
    m.ub = m.y; m.vb = al256(m.ub + (size_t)NEXP * DM * 2); m.idx = al256(m.vb + (size_t)NEXP * DM * 2); m.gate = al256(m.idx + (size_t)NTOK * PE * 4);
    return m;
}
inline Params make_params(void* const* d_in, void* d_out, void* d_ws) {
    Params p; memset(&p, 0, sizeof(p));
    const float* const* in = (const float* const*)d_in;
    p.x = in[0]; p.c = in[1]; p.ctx = in[2]; p.c_ctx = in[3]; p.w_mod = in[4]; p.b_mod = in[5]; p.norm_mix = in[6]; p.norm_ffn = in[7]; p.w_in = in[8]; p.conv_w = in[9];
    p.attn_sink = in[10]; p.na_rpb = in[11]; p.lb_logits = in[12]; p.group_norm = in[13]; p.w_out = in[14]; p.peer_wq = in[15]; p.peer_k1 = in[16]; p.peer_k2 = in[17];
    p.peer_u = in[18]; p.peer_v = in[19]; p.final_norm = in[20];
    p.out = (float*)d_out; char* w = (char*)d_ws; const WsMap m = ws_map();
    p.MOD = (float*)(w + m.mod); p.ROPE = (float*)(w + m.rope); p.TICKET = (int*)(w + m.ticket); p.WT = (bf16_t*)(w + m.wt); p.KB = (bf16_t*)(w + m.kb); p.CTXR = (float*)(w + m.ctxr);
    p.H = (bf16_t*)(w + m.h); p.P = (bf16_t*)(w + m.pp); p.Y = (bf16_t*)(w + m.y); p.OD = (float*)(w + m.od); p.ODH = (bf16_t*)(w + m.od); p.RB = (bf16_t*)(w + m.rb);
    p.Q = (bf16_t*)(w + m.q); p.CANDV = (float*)(w + m.candv); p.CANDI = (int*)(w + m.candi);
    p.UB = (bf16_t*)(w + m.ub); p.U8 = (unsigned char*)(w + m.u8); p.V8 = p.U8 + (size_t)NEXP * DM / 2; p.BAR = (unsigned*)(w + m.ticket + 256); p.VB = (bf16_t*)(w + m.vb); p.IDX = (int*)(w + m.idx); p.GATE = (float*)(w + m.gate);
    return p;
}

#ifndef HOST_EMU
typedef short bf16x8 __attribute__((ext_vector_type(8)));
typedef float f32x4 __attribute__((ext_vector_type(4)));
typedef unsigned u32x4 __attribute__((ext_vector_type(4)));
#define LAS __attribute__((address_space(3)))
DEV int otid() { int t = threadIdx.x; asm volatile("" : "+v"(t)); return t; }
#define GT ((long)blockIdx.x * blockDim.x + otid())
#define GS ((long)gridDim.x * blockDim.x)
typedef float f32x2 __attribute__((ext_vector_type(2)));
template <int CTRL> DEV float dppf(float x) { return __builtin_bit_cast(float, __builtin_amdgcn_update_dpp(0, __builtin_bit_cast(int, x), CTRL, 0xF, 0xF, false)); }
DEV float row16_sum(float x) { x += dppf<0x128>(x); x += dppf<0x124>(x); x += dppf<0x122>(x); x += dppf<0x121>(x); return x; }
DEV float rdlane(float x, int l) { return __builtin_bit_cast(float, __builtin_amdgcn_readlane(__builtin_bit_cast(int, x), l)); }
DEV float wave_sum(float x) { x = row16_sum(x); return (rdlane(x, 0) + rdlane(x, 16)) + (rdlane(x, 32) + rdlane(x, 48)); }
DEV float bflo(unsigned u) { return u2f(u << 16); }
DEV float bfhi(unsigned u) { return u2f(u & 0xffff0000u); }
typedef __bf16 hwbf2 __attribute__((ext_vector_type(2)));
DEV unsigned pack2bf(float a, float b) { const f32x2 v = {a, b}; return __builtin_bit_cast(unsigned, __builtin_convertvector(v, hwbf2)); }
DEV bf16_t f2bf_hw(float a) { return (bf16_t)(pack2bf(a, 0.f) & 0xffffu); }
DEV float rsq_fast(float a) { return __builtin_amdgcn_rsqf(a); }
DEV float silu_fast(float x) { return x * __builtin_amdgcn_rcpf(1.0f + __expf(-x)); }
DEV float gelu_fast(float x) { const float u = 0.7978845608028654f * (x + 0.044715f * x * x * x); const float t = 1.0f - 2.0f * __builtin_amdgcn_rcpf(1.0f + __expf(2.0f * u)); return 0.5f * x * (1.0f + t); }
DEV void unpack8(const u32x4& r, float* x) { x[0] = bflo(r.x); x[1] = bfhi(r.x); x[2] = bflo(r.y); x[3] = bfhi(r.y); x[4] = bflo(r.z); x[5] = bfhi(r.z); x[6] = bflo(r.w); x[7] = bfhi(r.w); }


DEV int gemm_m0(bool lat_only, int tm) { if (!lat_only) return tm * 128; const int per = SEQ / 128; return (tm / per) * TPB + CTXL + (tm % per) * 128; }
#define CE_DESC(a, b) { const float hi_ = fmaxf(a, b), lo_ = fminf(a, b); a = hi_; b = lo_; }
template <int N> DEV void bitonic_sort_desc(float (&v)[N]) {
#pragma unroll
    for (int k = 2; k <= N; k <<= 1)
#pragma unroll
        for (int j = k >> 1; j > 0; j >>= 1)
#pragma unroll
            for (int i = 0; i < N; ++i) { const int l = i ^ j; if (l > i) { if ((i & k) == 0 || k == N) { CE_DESC(v[i], v[l]); } else { CE_DESC(v[l], v[i]); } } }
}
template <int N> DEV void bitonic_merge_desc(float (&v)[N]) {
#pragma unroll
    for (int j = N >> 1; j > 0; j >>= 1)
#pragma unroll
        for (int i = 0; i < N; ++i) { const int l = i ^ j; if (l > i) { CE_DESC(v[i], v[l]); } }
}
DEV void peer_score_epilogue(const Params& p, int layer, int m0, int hh, const f32x4 (&acc)[4][4], char* smem, int tid, const u32x4 (&kreg)[8]) {
    const int lane = tid & 63, wave = tid >> 6, wr = wave >> 1, wc = wave & 1, c = lane & 15, g = lane >> 4;
    char* Qs = smem; char* Ks2 = smem + 32768;
    __syncthreads();
#pragma unroll
    for (int i = 0; i < 4; ++i)
#pragma unroll
        for (int j = 0; j < 4; ++j) { const int tok = wr * 64 + i * 16 + c, chunk = wc * 8 + j * 2 + (g >> 1);
            uint2 o; o.x = pack2bf(acc[i][j][0], acc[i][j][1]); o.y = pack2bf(acc[i][j][2], acc[i][j][3]);
            *(uint2*)(Qs + tok * 256 + ((chunk ^ (tok & 15)) << 4) + (g & 1) * 8) = o; }
    {
#pragma unroll
      for (int i = 0; i < 8; ++i) { const int q = tid + 256 * i, key = q >> 4, ch = q & 15; *(u32x4*)(Ks2 + key * 256 + ((ch ^ (key & 15)) << 4)) = kreg[i]; } }
    __syncthreads();
    f32x4 S[8][2];
#pragma unroll
    for (int kt = 0; kt < 8; ++kt) { S[kt][0] = (f32x4){0.f, 0.f, 0.f, 0.f}; S[kt][1] = (f32x4){0.f, 0.f, 0.f, 0.f}; }
#pragma unroll
    for (int kk = 0; kk < 4; ++kk) {
        bf16x8 qf[2];
#pragma unroll
        for (int tt = 0; tt < 2; ++tt) { const int tok = wave * 32 + tt * 16 + c; qf[tt] = *(const bf16x8*)(Qs + tok * 256 + (((4 * kk + g) ^ (tok & 15)) << 4)); }
#pragma unroll
        for (int kt = 0; kt < 8; ++kt) { const int key = kt * 16 + c; const bf16x8 kf = *(const bf16x8*)(Ks2 + key * 256 + (((4 * kk + g) ^ (key & 15)) << 4));
            S[kt][0] = __builtin_amdgcn_mfma_f32_16x16x32_bf16(kf, qf[0], S[kt][0], 0, 0, 0); S[kt][1] = __builtin_amdgcn_mfma_f32_16x16x32_bf16(kf, qf[1], S[kt][1], 0, 0, 0); }
    }
#pragma unroll
    for (int tt = 0; tt < 2; ++tt) {
        float A[16], B[16];
#pragma unroll
        for (int kt = 0; kt < 4; ++kt)
#pragma unroll
            for (int r = 0; r < 4; ++r) {
                A[kt * 4 + r] = u2f((f2u(S[kt][tt][r]) & ~0x7Fu) | (unsigned)(kt * 16 + 4 * g + r));
                B[kt * 4 + r] = u2f((f2u(S[kt + 4][tt][r]) & ~0x7Fu) | (unsigned)((kt + 4) * 16 + 4 * g + r)); }
        bitonic_sort_desc<16>(A); bitonic_sort_desc<16>(B);
#pragma unroll
        for (int j = 0; j < 16; ++j) A[j] = fmaxf(A[j], B[15 - j]);
        bitonic_merge_desc<16>(A);
#pragma unroll
        for (int rnd = 0; rnd < 2; ++rnd) {
#pragma unroll
            for (int j = 0; j < 16; ++j) B[j] = __shfl_xor(A[j], 16 << rnd, 64);
#pragma unroll
            for (int j = 0; j < 16; ++j) A[j] = fmaxf(A[j], B[15 - j]);
            bitonic_merge_desc<16>(A);
        }
        if (g == 0) { const int row = m0 + wave * 32 + tt * 16 + c; float* cv = p.CANDV + ((size_t)row * 16 + hh) * 16; int* ci = p.CANDI + ((size_t)row * 16 + hh) * 16;
#pragma unroll
            for (int j = 0; j < 16; j += 4) { *(float4*)(cv + j) = (float4){u2f(f2u(A[j]) & ~0x7Fu), u2f(f2u(A[j + 1]) & ~0x7Fu), u2f(f2u(A[j + 2]) & ~0x7Fu), u2f(f2u(A[j + 3]) & ~0x7Fu)};
                *(int4*)(ci + j) = (int4){(int)(f2u(A[j]) & 0x7Fu), (int)(f2u(A[j + 1]) & 0x7Fu), (int)(f2u(A[j + 2]) & 0x7Fu), (int)(f2u(A[j + 3]) & 0x7Fu)}; } }
    }
    __syncthreads();
}
DEV void gemm_tile_mfma(const Params& p, int layer, int mode, int m0, int n0, const bf16_t* Bt, char* smem) {
    const int tid = otid(), lane = tid & 63, wave = tid >> 6, wr = wave >> 1, wc = wave & 1, c = lane & 15, g = lane >> 4;
    const bf16_t* A = p.H + (size_t)m0 * DM; const bf16_t* B = Bt + (size_t)n0 * DM;
    f32x4 acc[4][4];
#pragma unroll
    for (int i = 0; i < 4; ++i)
#pragma unroll
        for (int j = 0; j < 4; ++j) acc[i][j] = (f32x4){0.f, 0.f, 0.f, 0.f};
    u32x4 kreg[8];
    constexpr int NK = DM / 64;
#define GEMM_STAGE(kt_, st_) { char* sa_ = smem + (st_) * 32768; \
        _Pragma("unroll") for (int i = 0; i < 4; ++i) { const int q = tid + 256 * i, row = q >> 3, ch = (q & 7) ^ (row & 7); \
            __builtin_amdgcn_global_load_lds((const unsigned*)(A + (size_t)row * DM + (kt_) * 64 + ch * 8), (LAS unsigned*)(sa_ + q * 16), 16, 0, 0); \
            __builtin_amdgcn_global_load_lds((const unsigned*)(B + (size_t)row * DM + (kt_) * 64 + ch * 8), (LAS unsigned*)(sa_ + 16384 + q * 16), 16, 0, 0); } }
    GEMM_STAGE(0, 0)
    for (int kt = 0; kt < NK; ++kt) {
        char* sa = smem + (kt & 1) * 32768; char* sb = sa + 16384;
        asm volatile("s_waitcnt vmcnt(0)" ::: "memory");
        __syncthreads();
        if (kt + 1 < NK) GEMM_STAGE(kt + 1, (kt + 1) & 1)
        if (mode == 2 && kt == NK - 1) {
            const bf16_t* kb = p.KB + ((size_t)layer * 2 + ((n0 >> 7) & 1)) * NKEYS * 128;
#pragma unroll
            for (int i = 0; i < 8; ++i) { const int q = tid + 256 * i, key = q >> 4, ch = q & 15; kreg[i] = *(const u32x4*)(kb + (size_t)key * 128 + ch * 8); }
        }
        bf16x8 fa[2][4], fb[2][4];
#pragma unroll
        for (int kk = 0; kk < 2; ++kk) {
            { const int row = wr * 64 + c; fa[kk][0] = *(const bf16x8*)(sa + row * 128 + (((kk * 4 + g) ^ (row & 7)) << 4)); }
#pragma unroll
            for (int j = 0; j < 4; ++j) { const int row = wc * 64 + j * 16 + c; fb[kk][j] = *(const bf16x8*)(sb + row * 128 + (((kk * 4 + g) ^ (row & 7)) << 4)); }
#pragma unroll
            for (int i = 1; i < 4; ++i) { const int row = wr * 64 + i * 16 + c; fa[kk][i] = *(const bf16x8*)(sa + row * 128 + (((kk * 4 + g) ^ (row & 7)) << 4)); }
        }
#pragma unroll
        for (int kk = 0; kk < 2; ++kk)
#pragma unroll
            for (int i = 0; i < 4; ++i)
#pragma unroll
                for (int j = 0; j < 4; ++j) acc[i][j] = __builtin_amdgcn_mfma_f32_16x16x32_bf16(fb[kk][j], fa[kk][i], acc[i][j], 0, 0, 0);
        __builtin_amdgcn_sched_group_barrier(0x100, 8, 0);
#pragma unroll
        for (int r = 0; r < 4; ++r) { __builtin_amdgcn_sched_group_barrier(0x008, 2, 0); __builtin_amdgcn_sched_group_barrier(0x100, 2, 0); }
        __builtin_amdgcn_sched_group_barrier(0x008, 24, 0);
        __builtin_amdgcn_sched_barrier(0);
    }
#undef GEMM_STAGE
    if (mode == 2) { peer_score_epilogue(p, layer, m0, n0 >> 7, acc, smem, tid, kreg); return; }
    if (mode == 0) {
        __syncthreads();
#pragma unroll
        for (int i = 0; i < 4; ++i) { const int rl = wr * 64 + i * 16 + c;
#pragma unroll
            for (int j = 0; j < 4; ++j) { uint2 o; o.x = pack2bf(acc[i][j][0], acc[i][j][1]); o.y = pack2bf(acc[i][j][2], acc[i][j][3]); *(uint2*)(smem + rl * 272 + (wc * 64 + j * 16 + 4 * g) * 2) = o; } }
        __syncthreads();
#pragma unroll
        for (int i = 0; i < 8; ++i) { const int q = tid + 256 * i, rl = q >> 4, ch = q & 15;
            *(u32x4*)(p.P + (size_t)(m0 + rl) * INW + n0 + ch * 8) = *(const u32x4*)(smem + rl * 272 + ch * 16); }
        __syncthreads();
        return;
    }
    float4 g1v[4];
    { const float* g1 = mod_row(p, layer, m0) + 2 * DM + n0 + wc * 64 + 4 * g;
#pragma unroll
      for (int j = 0; j < 4; ++j) g1v[j] = *(const float4*)(g1 + j * 16); }
    __syncthreads();
#pragma unroll
    for (int i = 0; i < 4; ++i) { const int rl = wr * 64 + i * 16 + c;
#pragma unroll
        for (int j = 0; j < 4; ++j) { const float4 gg = g1v[j];
            uint2 o; o.x = pack2bf(gg.x * acc[i][j][0], gg.y * acc[i][j][1]); o.y = pack2bf(gg.z * acc[i][j][2], gg.w * acc[i][j][3]); *(uint2*)(smem + rl * 272 + (wc * 64 + j * 16 + 4 * g) * 2) = o; } }
    __syncthreads();
    if (layer == 0) {
        f32x4 r0[8], r1[8];
#pragma unroll
        for (int i = 0; i < 8; ++i) { const int q = tid + 256 * i, rl = q >> 4, ch = q & 15; const float* rin = resid_in(p, 0, m0 + rl) + n0 + ch * 8; r0[i] = *(const f32x4*)rin; r1[i] = *(const f32x4*)(rin + 4); }
#pragma unroll
        for (int i = 0; i < 8; ++i) { const int q = tid + 256 * i, rl = q >> 4, ch = q & 15;
            float dl[8]; unpack8(*(const u32x4*)(smem + rl * 272 + ch * 16), dl);
            *(u32x4*)(p.RB + (size_t)(m0 + rl) * DM + n0 + ch * 8) = (u32x4){pack2bf(r0[i][0] + dl[0], r0[i][1] + dl[1]), pack2bf(r0[i][2] + dl[2], r0[i][3] + dl[3]), pack2bf(r1[i][0] + dl[4], r1[i][1] + dl[5]), pack2bf(r1[i][2] + dl[6], r1[i][3] + dl[7])}; }
    } else {
        u32x4 rb[8];
#pragma unroll
        for (int i = 0; i < 8; ++i) { const int q = tid + 256 * i, rl = q >> 4, ch = q & 15; rb[i] = *(const u32x4*)(p.RB + (size_t)(m0 + rl) * DM + n0 + ch * 8); }
#pragma unroll
        for (int i = 0; i < 8; ++i) { const int q = tid + 256 * i, rl = q >> 4, ch = q & 15;
            float dl[8], rv[8]; unpack8(*(const u32x4*)(smem + rl * 272 + ch * 16), dl); unpack8(rb[i], rv);
            *(u32x4*)(p.RB + (size_t)(m0 + rl) * DM + n0 + ch * 8) = (u32x4){pack2bf(rv[0] + dl[0], rv[1] + dl[1]), pack2bf(rv[2] + dl[2], rv[3] + dl[3]), pack2bf(rv[4] + dl[4], rv[5] + dl[5]), pack2bf(rv[6] + dl[6], rv[7] + dl[7])}; }
    }
    __syncthreads();
}
DEV void st_gemm_mfma(const Params& p, int layer, int mode, bool lat_only, char* smem, int bid, int nb) {
    const bf16_t* Bt; int N; gemm_cfg(p, layer, mode, Bt, N);
    const int ntm = (lat_only ? NLAT : NTOK) / 128, ntn = N / 128;
    if ((nb & 7) == 0) {
        const int xcd = bid & 7, li = bid >> 3, nl = nb >> 3;
        const int nown = (ntm - xcd + 7) / 8;
        int base = 0;
        for (int rg = 0; rg * 8 < nown; ++rg) {
            const int nr = (nown - rg * 8) < 8 ? (nown - rg * 8) : 8;
            for (int cg = 0; cg * 8 < ntn; ++cg) {
                const int nc = (ntn - cg * 8) < 8 ? (ntn - cg * 8) : 8;
                const int ps = nr * nc;
                for (int f = base + ((li - base % nl) + nl) % nl; f < base + ps; f += nl) {
                    const int q = f - base, r = q / nc, c = q % nc;
                    gemm_tile_mfma(p, layer, mode, gemm_m0(lat_only, xcd + 8 * (rg * 8 + r)), (cg * 8 + c) * 128, Bt, smem);
                }
                base += ps;
            }
        }
    } else {
        for (int t = bid; t < ntm * ntn; t += nb) { const int tn = t % ntn, tm = t / ntn; gemm_tile_mfma(p, layer, mode, gemm_m0(lat_only, tm), tn * 128, Bt, smem); }
    }
}

DEV void st_gemm_ctx_last(const Params& p, int layer, char* smem, int bid, int nb) {
    const bf16_t* Bt; int N; gemm_cfg(p, layer, 0, Bt, N);
    constexpr int NCT = BATCH * (CTXL / 128), NCC = 14;
    for (int t = bid; t < NCT * NCC; t += nb) {
        const int ct = t / NCC, j = t - ct * NCC;
        const int tn = (j < 2) ? 2 + j : ((j < 6) ? 4 + j : 10 + j);
        const int m0 = (ct / (CTXL / 128)) * TPB + (ct % (CTXL / 128)) * 128;
        gemm_tile_mfma(p, layer, 0, m0, tn * 128, Bt, smem);
    }
}
DEV void st_norm_fast(const Params& p, int layer, int which, bool lat_only) {
    const int tid_ = otid(), lane = tid_ & 63, wg = blockIdx.x * 4 + (tid_ >> 6), nw = gridDim.x * 4;
    const int nrows = lat_only ? NLAT : NTOK;
    const float* g = (which ? p.norm_ffn : p.norm_mix) + (size_t)layer * DM;
    constexpr int NRF = 8;
    float4 gv[4];
#pragma unroll
    for (int j = 0; j < 4; ++j) gv[j] = ((const float4*)g)[lane + 64 * j];
    const int per = (nrows + nw - 1) / nw; const int rbeg = wg * per, rend = (rbeg + per < nrows) ? rbeg + per : nrows;
    for (int i = rbeg; i < rend; i += NRF) {
        int rows[NRF]; bool has[NRF]; float4 v[NRF][4];
#pragma unroll
        for (int u = 0; u < NRF; ++u) {
            has[u] = (i + u) < rend; const int ii = has[u] ? i + u : i; rows[u] = lat_only ? lat_row(ii) : ii;
            if (which == 0) {
                const float4* xr = (const float4*)resid_in(p, layer, rows[u]);
#pragma unroll
                for (int j = 0; j < 4; ++j) v[u][j] = xr[lane + 64 * j];
            } else {
                const uint2* xr = (const uint2*)(p.RB + (size_t)rows[u] * DM);
#pragma unroll
                for (int j = 0; j < 4; ++j) { const uint2 t = xr[lane + 64 * j]; v[u][j] = (float4){bflo(t.x), bfhi(t.x), bflo(t.y), bfhi(t.y)}; }
            }
        }
        const int ilast = (i + NRF - 1 < rend) ? i + NRF - 1 : rend - 1;
        const float* mA = mod_row(p, layer, rows[0]); const float* mB = mod_row(p, layer, lat_only ? lat_row(ilast) : ilast);
        const bool uni = (mA == mB);
        float4 scv[4], shv[4];
        if (uni) {
#pragma unroll
            for (int j = 0; j < 4; ++j) { shv[j] = ((const float4*)(mA + (which ? 3 : 0) * DM))[lane + 64 * j]; scv[j] = ((const float4*)(mA + (which ? 4 : 1) * DM))[lane + 64 * j]; }
        }
#pragma unroll
        for (int u = 0; u < NRF; ++u) {
            if (!has[u]) continue;
            const int row = rows[u];
            float ss = 0.f;
#pragma unroll
            for (int j = 0; j < 4; ++j) ss += v[u][j].x * v[u][j].x + v[u][j].y * v[u][j].y + v[u][j].z * v[u][j].z + v[u][j].w * v[u][j].w;
            ss = wave_sum(ss);
            const float rs = rsq_fast(ss * (1.0f / DM) + EPS);
            uint2* h = (uint2*)(p.H + (size_t)row * DM);
            if (!uni) { const float* m = mod_row(p, layer, row);
#pragma unroll
                for (int j = 0; j < 4; ++j) { shv[j] = ((const float4*)(m + (which ? 3 : 0) * DM))[lane + 64 * j]; scv[j] = ((const float4*)(m + (which ? 4 : 1) * DM))[lane + 64 * j]; } }
#pragma unroll
            for (int j = 0; j < 4; ++j) { const int q = lane + 64 * j; const float4 gg = gv[j], s1 = scv[j], s0 = shv[j];
                uint2 o; o.x = pack2bf(v[u][j].x * rs * gg.x * (1.0f + s1.x) + s0.x, v[u][j].y * rs * gg.y * (1.0f + s1.y) + s0.y);
                o.y = pack2bf(v[u][j].z * rs * gg.z * (1.0f + s1.z) + s0.z, v[u][j].w * rs * gg.w * (1.0f + s1.w) + s0.w); h[q] = o; }
        }
    }
}
DEV void st_norm2_fast(const Params& p, int layer, bool lat_only) {
    const int tid_ = otid(), lane = tid_ & 63, wg = blockIdx.x * 4 + (tid_ >> 6), nw = gridDim.x * 4;
    const int nrows = lat_only ? NLAT : NTOK;
    const float* g = p.norm_ffn + (size_t)layer * DM;
    constexpr int NR2 = 16;
    float4 gv[4];
#pragma unroll
    for (int j = 0; j < 4; ++j) gv[j] = ((const float4*)g)[lane + 64 * j];
    const int per = (nrows + nw - 1) / nw; const int rbeg = wg * per, rend = (rbeg + per < nrows) ? rbeg + per : nrows;
    for (int i = rbeg; i < rend; i += NR2) {
        uint2 vp[NR2][4];
#pragma unroll
        for (int u = 0; u < NR2; ++u) {
            const int ii = (i + u < rend) ? i + u : i; const int row = lat_only ? lat_row(ii) : ii;
            const uint2* xr = (const uint2*)(p.RB + (size_t)row * DM);
#pragma unroll
            for (int j = 0; j < 4; ++j) vp[u][j] = xr[lane + 64 * j];
        }
        const int ilast = (i + NR2 - 1 < rend) ? i + NR2 - 1 : rend - 1;
        const float* mA = mod_row(p, layer, lat_only ? lat_row(i) : i); const float* mB = mod_row(p, layer, lat_only ? lat_row(ilast) : ilast);
        const bool uni = (mA == mB);
        float4 scv[4], shv[4];
        if (uni) {
#pragma unroll
            for (int j = 0; j < 4; ++j) { shv[j] = ((const float4*)(mA + 3 * DM))[lane + 64 * j]; scv[j] = ((const float4*)(mA + 4 * DM))[lane + 64 * j]; }
        }
#pragma unroll
        for (int u = 0; u < NR2; ++u) {
            if (i + u >= rend) continue;
            const int row = lat_only ? lat_row(i + u) : i + u;
            float4 v[4]; float ss = 0.f;
#pragma unroll
            for (int j = 0; j < 4; ++j) { const uint2 t = vp[u][j]; v[j] = (float4){bflo(t.x), bfhi(t.x), bflo(t.y), bfhi(t.y)}; ss += v[j].x * v[j].x + v[j].y * v[j].y + v[j].z * v[j].z + v[j].w * v[j].w; }
            ss = wave_sum(ss);
            const float rs = rsq_fast(ss * (1.0f / DM) + EPS);
            uint2* h = (uint2*)(p.H + (size_t)row * DM);
            if (!uni) { const float* m = mod_row(p, layer, row);
#pragma unroll
                for (int j = 0; j < 4; ++j) { shv[j] = ((const float4*)(m + 3 * DM))[lane + 64 * j]; scv[j] = ((const float4*)(m + 4 * DM))[lane + 64 * j]; } }
#pragma unroll
            for (int j = 0; j < 4; ++j) { const int q = lane + 64 * j; const float4 gg = gv[j], s1 = scv[j], s0 = shv[j];
                uint2 o; o.x = pack2bf(v[j].x * rs * gg.x * (1.0f + s1.x) + s0.x, v[j].y * rs * gg.y * (1.0f + s1.y) + s0.y);
                o.y = pack2bf(v[j].z * rs * gg.z * (1.0f + s1.z) + s0.z, v[j].w * rs * gg.w * (1.0f + s1.w) + s0.w); h[q] = o; }
        }
    }
}
DEV void st_final_fast(const Params& p) {
    const int tid_ = otid(), lane = tid_ & 63, wg = blockIdx.x * 4 + (tid_ >> 6), nw = gridDim.x * 4;
    for (int i = wg; i < NLAT; i += nw) {
        float4* xr = (float4*)(p.out + (size_t)i * DM); float4 v[4]; float ss = 0.f;
#pragma unroll
        for (int j = 0; j < 4; ++j) { v[j] = xr[lane + 64 * j]; ss += v[j].x * v[j].x + v[j].y * v[j].y + v[j].z * v[j].z + v[j].w * v[j].w; }
        ss = wave_sum(ss);
        const float rs = rsq_fast(ss * (1.0f / DM) + EPS);
#pragma unroll
        for (int j = 0; j < 4; ++j) { const float4 gg = ((const float4*)p.final_norm)[lane + 64 * j]; float4 o; o.x = v[j].x * rs * gg.x; o.y = v[j].y * rs * gg.y; o.z = v[j].z * rs * gg.z; o.w = v[j].w * rs * gg.w; xr[lane + 64 * j] = o; }
    }
}
struct MergeIn { uint2 ya, yb, cc[3], cx[3], cb, dg, o0, o1; };
DEV void merge_load(const Params& p, int row, int c4, MergeIn& m) {
    const int pp = row % TPB; const bool isctx = pp < CTXL; const int lo = isctx ? 0 : CTXL, hi = isctx ? CTXL - 1 : TPB - 1;
    const bf16_t* pr = p.P + (size_t)row * INW;
    m.ya = *(const uint2*)(p.Y + (size_t)row * 512 + c4); m.yb = *(const uint2*)(p.Y + (size_t)row * 512 + 256 + c4);
#pragma unroll
    for (int j = 0; j < 3; ++j) { const int q = pp + j - 1; const bf16_t* nr = pr + ((q >= lo && q <= hi) ? (ptrdiff_t)(j - 1) * INW : 0);
        m.cc[j] = *(const uint2*)(nr + C_CC + c4); m.cx[j] = *(const uint2*)(nr + C_CX + c4); }
    m.cb = *(const uint2*)(pr + C_CB + c4); m.dg = *(const uint2*)(pr + C_DG + c4);
    m.o0 = *(const uint2*)(p.ODH + (size_t)row * 256 + c4); m.o1 = *(const uint2*)(p.ODH + ((size_t)NTOK + row) * 256 + c4);
}
DEV void merge_compute(const Params& p, int row, int c4, const MergeIn& m, const float4 (&cwv)[3], const float4 (&gnv)[4]) {
    const int pp = row % TPB; const bool isctx = pp < CTXL; const int lo = isctx ? 0 : CTXL, hi = isctx ? CTXL - 1 : TPB - 1;
    float y[4][4];
    y[0][0] = bflo(m.ya.x); y[0][1] = bfhi(m.ya.x); y[0][2] = bflo(m.ya.y); y[0][3] = bfhi(m.ya.y); y[1][0] = bflo(m.yb.x); y[1][1] = bfhi(m.yb.x); y[1][2] = bflo(m.yb.y); y[1][3] = bfhi(m.yb.y);
    { float acc[4] = {0.f, 0.f, 0.f, 0.f};
#pragma unroll
      for (int j = 0; j < 3; ++j) { const int q = pp + j - 1; const float ok = (q >= lo && q <= hi) ? 1.0f : 0.0f; const float4 w = cwv[j];
          acc[0] += ok * w.x * bflo(m.cc[j].x) * bflo(m.cx[j].x); acc[1] += ok * w.y * bfhi(m.cc[j].x) * bfhi(m.cx[j].x); acc[2] += ok * w.z * bflo(m.cc[j].y) * bflo(m.cx[j].y); acc[3] += ok * w.w * bfhi(m.cc[j].y) * bfhi(m.cx[j].y); }
      y[2][0] = bflo(m.cb.x) * acc[0]; y[2][1] = bfhi(m.cb.x) * acc[1]; y[2][2] = bflo(m.cb.y) * acc[2]; y[2][3] = bfhi(m.cb.y) * acc[3]; }
    y[3][0] = (bflo(m.o0.x) + bflo(m.o1.x)) * silu_fast(bflo(m.dg.x)); y[3][1] = (bfhi(m.o0.x) + bfhi(m.o1.x)) * silu_fast(bfhi(m.dg.x));
    y[3][2] = (bflo(m.o0.y) + bflo(m.o1.y)) * silu_fast(bflo(m.dg.y)); y[3][3] = (bfhi(m.o0.y) + bfhi(m.o1.y)) * silu_fast(bfhi(m.dg.y));
#pragma unroll
    for (int g = 0; g < 4; ++g) {
        float ss = y[g][0] * y[g][0] + y[g][1] * y[g][1] + y[g][2] * y[g][2] + y[g][3] * y[g][3]; ss = wave_sum(ss);
        const float rs = rsq_fast(ss * (1.0f / 256.0f) + EPS); const float4 gg = gnv[g];
        uint2 o; o.x = pack2bf(y[g][0] * rs * gg.x, y[g][1] * rs * gg.y); o.y = pack2bf(y[g][2] * rs * gg.z, y[g][3] * rs * gg.w);
        *(uint2*)(p.H + (size_t)row * DM + g * 256 + c4) = o;
    }
}
DEV void st_merge_fast(const Params& p, int layer, bool lat_only) {
    const int tid_ = otid(), lane = tid_ & 63, wg = blockIdx.x * 4 + (tid_ >> 6), nw = gridDim.x * 4;
    const int nrows = lat_only ? NLAT : NTOK; const int c4 = 4 * lane;
    const float* cw = p.conv_w + (size_t)layer * 3 * 256; const float* gn = p.group_norm + (size_t)layer * DM;
    float4 cwv[3], gnv[4];
#pragma unroll
    for (int j = 0; j < 3; ++j) cwv[j] = *(const float4*)(cw + j * 256 + c4);
#pragma unroll
    for (int g = 0; g < 4; ++g) gnv[g] = *(const float4*)(gn + g * 256 + c4);
    for (int i = wg; i < nrows; i += 4 * nw) {
        int rows[4]; bool has[4]; MergeIn mi[4];
#pragma unroll
        for (int u = 0; u < 4; ++u) { has[u] = (i + u * nw) < nrows; const int ii = has[u] ? i + u * nw : i; rows[u] = lat_only ? lat_row(ii) : ii; merge_load(p, rows[u], c4, mi[u]); }
#pragma unroll
        for (int u = 0; u < 4; ++u) if (has[u]) merge_compute(p, rows[u], c4, mi[u], cwv, gnv);
    }
}
constexpr int HTB = 32;
constexpr int HNZ = HTB * 8, HNCH = 2 * HNZ + HTB * 4, HNR = (HNCH + 255) / 256;
constexpr int HST = HTB * 64 * 2 + HTB * 32;
DEV int hgrn_pp(int st, int dir) { if (st < CTXL) return dir ? CTXL - 1 - st : st; const int t = st - CTXL; return CTXL + (dir ? SEQ - 1 - t : t); }
DEV void hgrn_chunk(int cid, int vhalf, int& arr, int& s, int& ch) { if (cid < 2 * HNZ) { arr = cid / HNZ; s = (cid % HNZ) >> 3; ch = (cid & 7) * 8; } else { arr = 2; s = (cid - 2 * HNZ) >> 2; ch = vhalf * 32 + ((cid - 2 * HNZ) & 3) * 8; } }
DEV void hgrn_gates(const u32x4 (&r)[HNR], int tid, int vhalf, float* stage, const float* lbs) {
#pragma unroll
    for (int cix = 0; cix < HNR; ++cix) {
        const int cid = tid + 256 * cix; if (cid >= HNCH) break;
        int arr, s, ch; hgrn_chunk(cid, vhalf, arr, s, ch);
        float x[8]; unpack8(r[cix], x);
        if (arr == 0) {
            float f[8];
#pragma unroll
            for (int j = 0; j < 8; ++j) { const float lb = lbs[ch + j]; const float sg = 1.0f / (1.0f + __expf(-x[j])); f[j] = lb + (1.0f - lb) * sg; }
            float* F = stage + s * 64 + ch;
            *(float4*)F = (float4){f[0], f[1], f[2], f[3]}; *(float4*)(F + 4) = (float4){f[4], f[5], f[6], f[7]};
        } else {
            float* D = (arr == 1) ? stage + HTB * 64 + s * 64 + ch : stage + 2 * HTB * 64 + s * 32 + (ch - vhalf * 32);
            *(float4*)D = (float4){x[0], x[1], x[2], x[3]}; *(float4*)(D + 4) = (float4){x[4], x[5], x[6], x[7]};
        }
    }
}
DEV void hgrn_issue(const Params& p, const bf16_t* Pb, int h, int dir, int vhalf, int bt, int tid, u32x4 (&r)[HNR]) {
#pragma unroll
    for (int cix = 0; cix < HNR; ++cix) {
        const int cid = tid + 256 * cix; if (cid >= HNCH) break;
        int arr, s, ch; hgrn_chunk(cid, vhalf, arr, s, ch);
        const int col = (arr == 0 ? (dir ? C_DZB : C_DZF) : (arr == 1 ? C_DQ : C_DI)) + h * 64 + ch;
        r[cix] = *(const u32x4*)(Pb + (size_t)hgrn_pp(bt * HTB + s, dir) * INW + col);
    }
}
DEV void st_hgrn_item(const Params& p, int layer, char* smem, int item) {
    const int tid = otid(), lane = tid & 63, w = tid >> 6, dg = lane & 15, vg = lane >> 4;
    float* stg = (float*)smem;
    float* Ol = stg + 2 * HST;
    float* lbs = Ol + HTB * 32;
    constexpr int NB = TPB / HTB;
    {
        const int vhalf = item & 1, dir = (item >> 1) & 1, h = (item >> 2) & 3, b = item >> 4;
        const bf16_t* Pb = p.P + (size_t)b * TPB * INW;
        __syncthreads();
        if (tid < 64) lbs[tid] = hgrn_lb(p, layer, h * 64 + tid);
        __syncthreads();
        u32x4 r[HNR];
        hgrn_issue(p, Pb, h, dir, vhalf, 0, tid, r);
        hgrn_gates(r, tid, vhalf, stg, lbs);
        __syncthreads();
        float S[4][2];
#pragma unroll
        for (int i = 0; i < 4; ++i) { S[i][0] = 0.f; S[i][1] = 0.f; }
        for (int bt = 0; bt < NB; ++bt) {
            if (bt + 1 < NB) hgrn_issue(p, Pb, h, dir, vhalf, bt + 1, tid, r);
            const float* st = stg + (bt & 1) * HST;
#define HG_LOAD(F_, Q_, V_, S0) { _Pragma("unroll") for (int u = 0; u < 4; ++u) { const int s_ = (S0) + u; \
                F_[u] = *(const float4*)(st + s_ * 64 + 4 * dg); Q_[u] = *(const float4*)(st + HTB * 64 + s_ * 64 + 4 * dg); V_[u] = *(const float2*)(st + 2 * HTB * 64 + s_ * 32 + 8 * w + 2 * vg); } }
#define HG_COMP(F_, Q_, V_, S0) { float x[8]; \
                _Pragma("unroll") for (int u = 0; u < 4; ++u) { \
                    const float ff[4] = {F_[u].x, F_[u].y, F_[u].z, F_[u].w}, qq[4] = {Q_[u].x, Q_[u].y, Q_[u].z, Q_[u].w}; const float v0 = V_[u].x, v1 = V_[u].y; \
                    float pa = 0.f, pb = 0.f; \
                    _Pragma("unroll") for (int i = 0; i < 4; ++i) { S[i][0] = fmaf(ff[i], S[i][0] - v0, v0); S[i][1] = fmaf(ff[i], S[i][1] - v1, v1); pa = fmaf(S[i][0], qq[i], pa); pb = fmaf(S[i][1], qq[i], pb); } \
                    x[2 * u] = pa; x[2 * u + 1] = pb; } \
                float y[4], z[2]; \
                _Pragma("unroll") for (int k = 0; k < 4; ++k) { const float kp = b3 ? x[4 + k] : x[k], sd = b3 ? x[k] : x[4 + k]; y[k] = kp + dppf<0x140>(sd); } \
                _Pragma("unroll") for (int k = 0; k < 2; ++k) { const float kp = b2 ? y[2 + k] : y[k], sd = b2 ? y[k] : y[2 + k]; z[k] = kp + dppf<0x141>(sd); } \
                const float kp_ = b1 ? z[1] : z[0], sd_ = b1 ? z[0] : z[1]; float t = kp_ + dppf<0x4E>(sd_); \
                t += dppf<0xB1>(t); \
                if ((dg & 1) == 0) Ol[((S0) + (vi >> 1)) * 32 + 8 * w + 2 * vg + (vi & 1)] = t; }
            { const bool b3 = (dg & 8) != 0, b2 = (dg & 4) != 0, b1 = (dg & 2) != 0; const int vi = dg >> 1;
              float4 Fa[4], Qa[4], Fb[4], Qb[4]; float2 Va[4], Vb[4];
              HG_LOAD(Fa, Qa, Va, 0)
              for (int s0 = 0; s0 < HTB; s0 += 8) {
                  HG_LOAD(Fb, Qb, Vb, s0 + 4)
                  HG_COMP(Fa, Qa, Va, s0)
                  if (s0 + 8 < HTB) HG_LOAD(Fa, Qa, Va, s0 + 8)
                  HG_COMP(Fb, Qb, Vb, s0 + 4)
              } }
#undef HG_LOAD
#undef HG_COMP
            __syncthreads();
#pragma unroll
            for (int e = tid; e < HTB * 8; e += 256) { const int s = e >> 3, v4 = (e & 7) * 4; const int pp = hgrn_pp(bt * HTB + s, dir);
              *(float4*)(p.OD + ((size_t)dir * NTOK + (size_t)b * TPB + pp) * 256 + h * 64 + vhalf * 32 + v4) = *(const float4*)(Ol + s * 32 + v4); }
            if (bt + 1 < NB) hgrn_gates(r, tid, vhalf, stg + ((bt + 1) & 1) * HST, lbs);
            __syncthreads();
        }
    }
}
constexpr int HM_ROW = 144;
constexpr int HM_OQ = 0, HM_OK = 32 * HM_ROW, HM_OKT = 2 * 32 * HM_ROW, HM_OVT = HM_OKT + 4096, HM_OPR = HM_OVT + 4096, HM_OPE = HM_OPR + 512, HM_STG = HM_OPE + 512;
constexpr int HM_OF = 2 * HM_STG, HM_OQF = HM_OF + 8192, HM_OLB = HM_OQF + 8192;
static_assert(HM_OLB + 256 <= 65536, "hgrn LDS");
DEV void hgrnm_issue(const bf16_t* Pb, int h, int dir, int bt, int tid, u32x4 (&r)[3]) {
    const int s = tid >> 3, ch = (tid & 7) * 8;
    const bf16_t* row = Pb + (size_t)hgrn_pp(bt * 32 + s, dir) * INW + h * 64 + ch;
    r[0] = *(const u32x4*)(row + (dir ? C_DZB : C_DZF)); r[1] = *(const u32x4*)(row + C_DQ); r[2] = *(const u32x4*)(row + C_DI);
}
DEV void hgrnm_prep_a(const u32x4 (&r)[3], int tid, char* smem, char* stage) {
    const int s = tid >> 3, ch = (tid & 7) * 8; const float* lbs = (const float*)(smem + HM_OLB);
    float x[8], f[8];
    unpack8(r[0], x);
#pragma unroll
    for (int j = 0; j < 8; ++j) { const float lb = lbs[ch + j]; const float sg = __builtin_amdgcn_rcpf(1.0f + __expf(-x[j])); f[j] = lb + (1.0f - lb) * sg; }
    float* F = (float*)(smem + HM_OF) + s * 64 + ch;
    *(float4*)F = (float4){f[0], f[1], f[2], f[3]}; *(float4*)(F + 4) = (float4){f[4], f[5], f[6], f[7]};
    unpack8(r[1], x);
    float* Q = (float*)(smem + HM_OQF) + s * 64 + ch;
    *(float4*)Q = (float4){x[0], x[1], x[2], x[3]}; *(float4*)(Q + 4) = (float4){x[4], x[5], x[6], x[7]};
    bf16_t* vt = (bf16_t*)(stage + HM_OVT) + ((s >> 4) * 64 + ch) * 16 + (s & 15);
    const unsigned w4[4] = {r[2].x, r[2].y, r[2].z, r[2].w};
#pragma unroll
    for (int j = 0; j < 4; ++j) { vt[(2 * j) * 16] = (bf16_t)(w4[j] & 0xffffu); vt[(2 * j + 1) * 16] = (bf16_t)(w4[j] >> 16); }
}
DEV void hgrnm_prep_b(int tid, char* smem, char* stage) {
    const int d = tid & 63, c = (tid >> 6) & 1, half = tid >> 7;
    const float* F = (const float*)(smem + HM_OF) + (c * 16) * 64 + d; const float* Q = (const float*)(smem + HM_OQF) + (c * 16) * 64 + d;
    bf16_t* qs = (bf16_t*)(stage + HM_OQ); bf16_t* ks = (bf16_t*)(stage + HM_OK);
    unsigned kt[4];
    float fv[8], qv8[8];
#pragma unroll
    for (int t = 0; t < 8; ++t) { fv[t] = F[(half * 8 + t) * 64]; qv8[t] = Q[(half * 8 + t) * 64]; }
    __builtin_amdgcn_sched_barrier(0);
    if (half == 0) {
        float up = 1.0f, fl = 1.0f;
#pragma unroll
        for (int t = 7; t >= 0; --t) {
            const float f = fv[t], q = qv8[t];
            const float qv = q * __builtin_amdgcn_rcpf(fmaxf(up, 1.0e-37f)), kv = (1.0f - f) * up;
            const unsigned qk = pack2bf(qv, kv); const bf16_t qb = (bf16_t)(qk & 0xffffu), kb = (bf16_t)(qk >> 16);
            qs[(c * 16 + t) * (HM_ROW / 2) + d] = qb; ks[(c * 16 + t) * (HM_ROW / 2) + d] = kb;
            if (t & 1) kt[t >> 1] = (unsigned)kb << 16; else kt[t >> 1] |= (unsigned)kb;
            fl = f; if (t > 0) up *= f;
        }
        ((float*)(stage + HM_OPR))[c * 64 + d] = up * fl;
    } else {
        float dn = 1.0f;
#pragma unroll
        for (int t = 8; t < 16; ++t) {
            const float f = fv[t - 8], q = qv8[t - 8];
            dn *= f;
            const float qv = q * dn, kv = (1.0f - f) * __builtin_amdgcn_rcpf(fmaxf(dn, 1.0e-37f));
            const unsigned qk = pack2bf(qv, kv); const bf16_t qb = (bf16_t)(qk & 0xffffu), kb = (bf16_t)(qk >> 16);
            qs[(c * 16 + t) * (HM_ROW / 2) + d] = qb; ks[(c * 16 + t) * (HM_ROW / 2) + d] = kb;
            if (t & 1) kt[(t - 8) >> 1] |= (unsigned)kb << 16; else kt[(t - 8) >> 1] = (unsigned)kb;
        }
        ((float*)(stage + HM_OPE))[c * 64 + d] = dn;
    }
    *(u32x4*)(stage + HM_OKT + ((c * 64 + d) * 16 + half * 8) * 2) = (u32x4){kt[0], kt[1], kt[2], kt[3]};
}
DEV void hgrnm_batch(const bf16_t* Pb, bf16_t* odb, char* smem, int h, int dir, int bt, int nbt, int tid, int w, int cl, int g, u32x4 (&rf)[3], const u32x4 (&rn)[3], f32x4 (&S)[4]) {
    if (bt + 4 < nbt) hgrnm_issue(Pb, h, dir, bt + 4, tid, rf);
    const char* stg = smem + (bt & 1) * HM_STG;
    u32x4 vfq[2]; f32x4 oi[2];
    { bf16x8 kf[2][2], qf[2][2]; uint2 vfr[2];
#pragma unroll
      for (int c = 0; c < 2; ++c) {
          const char* qrow = stg + HM_OQ + (c * 16 + cl) * HM_ROW; const char* krow = stg + HM_OK + (c * 16 + cl) * HM_ROW;
#pragma unroll
          for (int kk = 0; kk < 2; ++kk) { kf[c][kk] = *(const bf16x8*)(krow + (32 * kk + 8 * g) * 2); qf[c][kk] = *(const bf16x8*)(qrow + (32 * kk + 8 * g) * 2); }
          vfr[c] = *(const uint2*)(stg + HM_OVT + ((c * 64 + 16 * w + cl) * 16 + 4 * g) * 2);
      }
      __builtin_amdgcn_sched_barrier(0);
      f32x4 at[2];
#pragma unroll
      for (int c = 0; c < 2; ++c) { at[c] = (f32x4){0.f, 0.f, 0.f, 0.f};
#pragma unroll
          for (int kk = 0; kk < 2; ++kk) at[c] = __builtin_amdgcn_mfma_f32_16x16x32_bf16(kf[c][kk], qf[c][kk], at[c], 0, 0, 0); }
#pragma unroll
      for (int c = 0; c < 2; ++c) {
          u32x4 pa;
          pa.x = pack2bf((4 * g + 0 <= cl) ? at[c][0] : 0.f, (4 * g + 1 <= cl) ? at[c][1] : 0.f); pa.y = pack2bf((4 * g + 2 <= cl) ? at[c][2] : 0.f, (4 * g + 3 <= cl) ? at[c][3] : 0.f); pa.z = 0u; pa.w = 0u;
          vfq[c] = (u32x4){vfr[c].x, vfr[c].y, 0u, 0u};
          oi[c] = __builtin_amdgcn_mfma_f32_16x16x32_bf16(__builtin_bit_cast(bf16x8, pa), __builtin_bit_cast(bf16x8, vfq[c]), (f32x4){0.f, 0.f, 0.f, 0.f}, 0, 0, 0);
      } }
#pragma unroll
    for (int c = 0; c < 2; ++c) {
        uint2 qp0[2], qp1[2], kar[4]; float4 prv[4], pev[4];
        { const char* qrow = stg + HM_OQ + (c * 16 + cl) * HM_ROW;
#pragma unroll
          for (int kk = 0; kk < 2; ++kk) { qp0[kk] = *(const uint2*)(qrow + (16 * (2 * kk) + 4 * g) * 2); qp1[kk] = *(const uint2*)(qrow + (16 * (2 * kk + 1) + 4 * g) * 2); }
#pragma unroll
          for (int j = 0; j < 4; ++j) { prv[j] = *(const float4*)(stg + HM_OPR + (c * 64 + 16 * j + 4 * g) * 4); pev[j] = *(const float4*)(stg + HM_OPE + (c * 64 + 16 * j + 4 * g) * 4);
              kar[j] = *(const uint2*)(stg + HM_OKT + ((c * 64 + 16 * j + cl) * 16 + 4 * g) * 2); } }
#pragma unroll
        for (int j = 0; j < 4; ++j) { S[j][0] *= prv[j].x; S[j][1] *= prv[j].y; S[j][2] *= prv[j].z; S[j][3] *= prv[j].w; }
        f32x4 o = oi[c];
#pragma unroll
        for (int kk = 0; kk < 2; ++kk) {
            const u32x4 qa = (u32x4){qp0[kk].x, qp0[kk].y, qp1[kk].x, qp1[kk].y};
            const u32x4 sb = (u32x4){pack2bf(S[2 * kk][0], S[2 * kk][1]), pack2bf(S[2 * kk][2], S[2 * kk][3]), pack2bf(S[2 * kk + 1][0], S[2 * kk + 1][1]), pack2bf(S[2 * kk + 1][2], S[2 * kk + 1][3])};
            o = __builtin_amdgcn_mfma_f32_16x16x32_bf16(__builtin_bit_cast(bf16x8, qa), __builtin_bit_cast(bf16x8, sb), o, 0, 0, 0);
        }
#pragma unroll
        for (int j = 0; j < 4; ++j) {
            const u32x4 ka = (u32x4){kar[j].x, kar[j].y, 0u, 0u};
            S[j] = __builtin_amdgcn_mfma_f32_16x16x32_bf16(__builtin_bit_cast(bf16x8, ka), __builtin_bit_cast(bf16x8, vfq[c]), S[j], 0, 0, 0);
            S[j][0] *= pev[j].x; S[j][1] *= pev[j].y; S[j][2] *= pev[j].z; S[j][3] *= pev[j].w;
        }
#pragma unroll
        for (int i = 0; i < 4; ++i) odb[(size_t)hgrn_pp(bt * 32 + c * 16 + 4 * g + i, dir) * 256] = f2bf_hw(o[i]);
    }
    if (bt + 1 < nbt) {
        char* nst = smem + ((bt + 1) & 1) * HM_STG;
        hgrnm_prep_a(rn, tid, smem, nst);
        __syncthreads();
        hgrnm_prep_b(tid, smem, nst);
    }
    __syncthreads();
}
DEV void st_hgrn_mfma(const Params& p, int layer, char* smem, int item) {
    const int tid = otid(), lane = tid & 63, w = tid >> 6, cl = lane & 15, g = lane >> 4;
    constexpr int NB = TPB / 32;
    static_assert(NB % 4 == 0, "hgrn batch ring");
    const int dir = item & 1, h = (item >> 1) & 3, b = item >> 3;
    const bf16_t* Pb = p.P + (size_t)b * TPB * INW;
    __builtin_amdgcn_s_setprio(3);
    __syncthreads();
    if (tid < 64) ((float*)(smem + HM_OLB))[tid] = hgrn_lb(p, layer, h * 64 + tid);
    __syncthreads();
    u32x4 r0[3], r1[3], r2[3], r3[3];
    hgrnm_issue(Pb, h, dir, 0, tid, r0); hgrnm_issue(Pb, h, dir, 1, tid, r1); hgrnm_issue(Pb, h, dir, 2, tid, r2); hgrnm_issue(Pb, h, dir, 3, tid, r3);
    hgrnm_prep_a(r0, tid, smem, smem);
    __syncthreads();
    hgrnm_prep_b(tid, smem, smem);
    __syncthreads();
    f32x4 S[4];
#pragma unroll
    for (int j = 0; j < 4; ++j) S[j] = (f32x4){0.f, 0.f, 0.f, 0.f};
    bf16_t* odb = p.ODH + ((size_t)dir * NTOK + (size_t)b * TPB) * 256 + h * 64 + 16 * w + cl;
    for (int bt = 0; bt < NB; bt += 4) {
        hgrnm_batch(Pb, odb, smem, h, dir, bt, NB, tid, w, cl, g, r0, r1, S);
        hgrnm_batch(Pb, odb, smem, h, dir, bt + 1, NB, tid, w, cl, g, r1, r2, S);
        hgrnm_batch(Pb, odb, smem, h, dir, bt + 2, NB, tid, w, cl, g, r2, r3, S);
        hgrnm_batch(Pb, odb, smem, h, dir, bt + 3, NB, tid, w, cl, g, r3, r0, S);
    }
    __builtin_amdgcn_s_setprio(0);
}
DEV void st_peer_expert_fast(const Params& p, int layer, bool lat_only) {
    const int tid_ = otid(), lane = tid_ & 63, wg = blockIdx.x * 4 + (tid_ >> 6), nw = gridDim.x * 4;
    const int nrows = lat_only ? NLAT : NTOK;
    for (int i = wg; i < nrows; i += nw) {
        const int row = lat_only ? lat_row(i) : i;
        float hf[16], acc[16];
        { const bf16_t* hp = p.H + (size_t)row * DM; const u32x4 h0 = *(const u32x4*)(hp + 8 * lane), h1 = *(const u32x4*)(hp + 512 + 8 * lane); unpack8(h0, hf); unpack8(h1, hf + 8); }
#pragma unroll
        for (int k = 0; k < 16; ++k) acc[k] = 0.f;
        const int* idx = p.IDX + (size_t)row * PE; const float* gate = p.GATE + (size_t)row * PE;
        for (int e0 = 0; e0 < PE; e0 += 4) {
            u32x4 ur[4][2], vr[4][2]; float gt[4];
#pragma unroll
            for (int j = 0; j < 4; ++j) { const int id = __builtin_amdgcn_readfirstlane(idx[e0 + j]); gt[j] = gate[e0 + j];
                const bf16_t* up = p.UB + (size_t)id * DM; const bf16_t* vp = p.VB + (size_t)id * DM;
                ur[j][0] = *(const u32x4*)(up + 8 * lane); ur[j][1] = *(const u32x4*)(up + 512 + 8 * lane); vr[j][0] = *(const u32x4*)(vp + 8 * lane); vr[j][1] = *(const u32x4*)(vp + 512 + 8 * lane); }
#pragma unroll
            for (int j = 0; j < 4; ++j) {
                float x[16]; unpack8(ur[j][0], x); unpack8(ur[j][1], x + 8); float d = 0.f;
#pragma unroll
                for (int k = 0; k < 16; ++k) d += hf[k] * x[k];
                d = wave_sum(d);
                const float a = gt[j] * gelu_tanh_(d);
                unpack8(vr[j][0], x); unpack8(vr[j][1], x + 8);
#pragma unroll
                for (int k = 0; k < 16; ++k) acc[k] += a * x[k];
            }
        }
        float* xr = resid_out(p, row); const float* g2 = mod_row(p, layer, row) + 5 * DM;
#pragma unroll
        for (int hh = 0; hh < 2; ++hh)
#pragma unroll
            for (int q = 0; q < 2; ++q) { const int e = hh * 512 + 8 * lane + 4 * q; float4 xv = *(float4*)(xr + e); const float4 gg = *(const float4*)(g2 + e);
                xv.x += gg.x * acc[hh * 8 + 4 * q]; xv.y += gg.y * acc[hh * 8 + 4 * q + 1]; xv.z += gg.z * acc[hh * 8 + 4 * q + 2]; xv.w += gg.w * acc[hh * 8 + 4 * q + 3]; *(float4*)(xr + e) = xv; }
    }
}

typedef short s16x4 __attribute__((ext_vector_type(4)));
constexpr int AT_ROWB = 160;
constexpr int AT_TILE = 64 * AT_ROWB;
constexpr int AT_STAGE = 2 * AT_TILE;
struct AttnUnit { int type, b, h, qrow0, qpos0, ntiles, rp; bool rope, has_sink; int qcol, kcol, vcol, ycol; float sink; };
DEV float shfl_xor_f(float x, int m) { return __shfl_xor(x, m, 64); }
DEV void attn_issue(const Params& p, const AttnUnit& u, int tb, int kp0, int tid, u32x4 (&rk)[4], u32x4 (&rv)[2]) {
    const int j = tid >> 2, cq = tid & 3; const bf16_t* pr = p.P + (size_t)(tb + j) * INW;
    rk[0] = *(const u32x4*)(pr + u.kcol + 16 * cq); rk[1] = *(const u32x4*)(pr + u.kcol + 16 * cq + 8);
    if (u.rope && kp0 >= 0) { rk[2] = *(const u32x4*)(pr + u.kcol + 16 * (cq ^ 1)); rk[3] = *(const u32x4*)(pr + u.kcol + 16 * (cq ^ 1) + 8); }
    rv[0] = *(const u32x4*)(pr + u.vcol + 16 * cq); rv[1] = *(const u32x4*)(pr + u.vcol + 16 * cq + 8);
}
DEV void attn_write(const Params& p, const AttnUnit& u, int kp0, int tid, const u32x4 (&rk)[4], const u32x4 (&rv)[2], char* stage) {
    const int j = tid >> 2, cq = tid & 3; char* kd = stage + j * AT_ROWB + cq * 32; char* vd = stage + AT_TILE + j * AT_ROWB + cq * 32;
    if (u.rope && kp0 >= 0) {
        const int kp = kp0 + j; const int pos = (cq < 2) ? (kp >> 6) : (kp & 63); const float sgn = (cq & 1) ? 1.0f : -1.0f;
        float xo[16], xp[16]; unpack8(rk[0], xo); unpack8(rk[1], xo + 8); unpack8(rk[2], xp); unpack8(rk[3], xp + 8);
        const float4* cs = (const float4*)(p.ROPE + pos * 16); const float4* sn = (const float4*)(p.ROPE + 1024 + pos * 16);
        float o[16];
#pragma unroll
        for (int q = 0; q < 4; ++q) { const float4 c4 = cs[q], s4 = sn[q];
            o[4 * q] = xo[4 * q] * c4.x + sgn * xp[4 * q] * s4.x; o[4 * q + 1] = xo[4 * q + 1] * c4.y + sgn * xp[4 * q + 1] * s4.y;
            o[4 * q + 2] = xo[4 * q + 2] * c4.z + sgn * xp[4 * q + 2] * s4.z; o[4 * q + 3] = xo[4 * q + 3] * c4.w + sgn * xp[4 * q + 3] * s4.w; }
        u32x4 a, b; a.x = pack2bf(o[0], o[1]); a.y = pack2bf(o[2], o[3]); a.z = pack2bf(o[4], o[5]); a.w = pack2bf(o[6], o[7]);
        b.x = pack2bf(o[8], o[9]); b.y = pack2bf(o[10], o[11]); b.z = pack2bf(o[12], o[13]); b.w = pack2bf(o[14], o[15]);
        *(u32x4*)kd = a; *(u32x4*)(kd + 16) = b;
    } else { *(u32x4*)kd = rk[0]; *(u32x4*)(kd + 16) = rk[1]; }
    *(u32x4*)vd = rv[0]; *(u32x4*)(vd + 16) = rv[1];
}
DEV void attn_tile(const AttnUnit& u, int ti, int& tb, int& kp0) {
    const int nloc = u.ntiles - CTXL / 64;
    if (ti < nloc) { kp0 = u.qpos0 + u.rp + 64 * ti; tb = u.b * TPB + CTXL + kp0; }
    else { kp0 = -1; tb = u.b * TPB + 64 * (ti - nloc); }
}
DEV void attn_unit(const Params& p, int layer, const AttnUnit& u, char* smem) {
    const int tid = otid(), lane = tid & 63, w = tid >> 6, c = lane & 15, g = lane >> 4;
    char* stg = smem; float* rpbs = (float*)(smem + 2 * AT_STAGE);
    __syncthreads();
    if (u.type == 1) { const float* rpb = p.na_rpb + ((size_t)layer * 4 + u.h) * 465; for (int i = tid; i < 465; i += 256) rpbs[i] = rpb[i]; }
    u32x4 rk[4], rv[2]; int tb, kp0, kp0n = -1;
    attn_tile(u, 0, tb, kp0);
    attn_issue(p, u, tb, kp0, tid, rk, rv);
    bf16x8 qf[2][2];
#pragma unroll
    for (int qt = 0; qt < 2; ++qt) {
        const int qi = 32 * w + 16 * qt + c; const bf16_t* qr = p.P + (size_t)(u.qrow0 + qi) * INW + u.qcol;
#pragma unroll
        for (int kk = 0; kk < 2; ++kk) {
            const u32x4 own = *(const u32x4*)(qr + 32 * kk + 8 * g); float xo[8], o[8]; unpack8(own, xo);
            if (u.rope) {
                const u32x4 par = *(const u32x4*)(qr + 32 * kk + 8 * (g ^ 2)); float xp[8]; unpack8(par, xp);
                const int t = u.qpos0 + qi; const int pos = kk ? (t & 63) : (t >> 6); const float sgn = (g & 2) ? 1.0f : -1.0f;
                const float* cs = p.ROPE + pos * 16 + 8 * (g & 1); const float* sn = p.ROPE + 1024 + pos * 16 + 8 * (g & 1);
#pragma unroll
                for (int j = 0; j < 8; ++j) o[j] = (xo[j] * cs[j] + sgn * xp[j] * sn[j]) * 0.125f;
            } else {
#pragma unroll
                for (int j = 0; j < 8; ++j) o[j] = xo[j] * 0.125f;
            }
            u32x4 pk; pk.x = pack2bf(o[0], o[1]); pk.y = pack2bf(o[2], o[3]); pk.z = pack2bf(o[4], o[5]); pk.w = pack2bf(o[6], o[7]);
            qf[qt][kk] = __builtin_bit_cast(bf16x8, pk);
        }
    }
    f32x4 O[4][2]; float m[2], l[2];
#pragma unroll
    for (int i = 0; i < 4; ++i) { O[i][0] = (f32x4){0.f, 0.f, 0.f, 0.f}; O[i][1] = (f32x4){0.f, 0.f, 0.f, 0.f}; }
    m[0] = m[1] = MASKV; l[0] = l[1] = 0.f;
    attn_write(p, u, kp0, tid, rk, rv, stg);
    __syncthreads();
    for (int ti = 0; ti < u.ntiles; ++ti) {
        if (ti + 1 < u.ntiles) { attn_tile(u, ti + 1, tb, kp0n); attn_issue(p, u, tb, kp0n, tid, rk, rv); }
        const char* ks = stg + (ti & 1) * AT_STAGE; const char* vs = ks + AT_TILE;
        bool tskip = false, tmask = true;
        if (kp0 >= 0) {
            const int wv = __builtin_amdgcn_readfirstlane(w);
            if (u.type == 0) { const int qlo = u.qpos0 + 32 * wv, qhi = qlo + 31, klo = kp0, khi = kp0 + 63;
                tskip = (qlo - khi > 128) || (klo - qhi > 128); tmask = (qhi - klo > 128) || (khi - qlo > 128); }
            else if (u.type == 1) { const int rq = (u.qpos0 >> 6) + (wv >> 1); const int rs = clampi(rq - 4, 0, ROWS - 8); const int kr = kp0 >> 6; tskip = (kr < rs) || (kr >= rs + 8); }
        }
        if (!tskip) {
        f32x4 S[4][2];
#pragma unroll
        for (int kt = 0; kt < 4; ++kt) {
            const bf16x8 ka = *(const bf16x8*)(ks + (16 * kt + c) * AT_ROWB + 16 * g), kb = *(const bf16x8*)(ks + (16 * kt + c) * AT_ROWB + 64 + 16 * g);
#pragma unroll
            for (int qt = 0; qt < 2; ++qt) { f32x4 a = (f32x4){0.f, 0.f, 0.f, 0.f}; a = __builtin_amdgcn_mfma_f32_16x16x32_bf16(ka, qf[qt][0], a, 0, 0, 0); a = __builtin_amdgcn_mfma_f32_16x16x32_bf16(kb, qf[qt][1], a, 0, 0, 0); S[kt][qt] = a; }
        }
        if (kp0 >= 0) {
            if (u.type == 0 && tmask) {
#pragma unroll
                for (int qt = 0; qt < 2; ++qt) { const int qp = u.qpos0 + 32 * w + 16 * qt + c;
#pragma unroll
                    for (int kt = 0; kt < 4; ++kt)
#pragma unroll
                        for (int r = 0; r < 4; ++r) { const int d = qp - (kp0 + 16 * kt + 4 * g + r); if (d > 128 || d < -128) S[kt][qt][r] = MASKV; } }
            } else if (u.type == 1) {
                const int kr = kp0 >> 6;
#pragma unroll
                for (int qt = 0; qt < 2; ++qt) { const int qi = 32 * w + 16 * qt + c; const int rq = (u.qpos0 >> 6) + (qi >> 6), qc = qi & 63; const int rs = clampi(rq - 4, 0, ROWS - 8), w0 = clampi(qc - 8, 0, GRIDW - 16);
                    const bool rowok = (kr >= rs) && (kr < rs + 8); const int boff = (kr - rq + 7) * 31 - qc + 15;
#pragma unroll
                    for (int kt = 0; kt < 4; ++kt)
#pragma unroll
                        for (int r = 0; r < 4; ++r) { const int kc = 16 * kt + 4 * g + r; const bool ok = rowok && (kc >= w0) && (kc < w0 + 16); const int bi = ok ? boff + kc : 0; const float bv = rpbs[bi]; S[kt][qt][r] = ok ? S[kt][qt][r] + bv : MASKV; } }
            }
        }
        bf16x8 pf[2][2];
#pragma unroll
        for (int qt = 0; qt < 2; ++qt) {
            float mx = S[0][qt][0];
#pragma unroll
            for (int kt = 0; kt < 4; ++kt)
#pragma unroll
                for (int r = 0; r < 4; ++r) mx = fmaxf(mx, S[kt][qt][r]);
            mx = fmaxf(mx, shfl_xor_f(mx, 16)); mx = fmaxf(mx, shfl_xor_f(mx, 32));
            const float mn = fmaxf(m[qt], mx); const float al = __expf(m[qt] - mn); m[qt] = mn;
            float ps = 0.f; float pv[4][4];
#pragma unroll
            for (int kt = 0; kt < 4; ++kt)
#pragma unroll
                for (int r = 0; r < 4; ++r) { pv[kt][r] = __expf(S[kt][qt][r] - mn); ps += pv[kt][r]; }
            l[qt] = l[qt] * al + ps;
#pragma unroll
            for (int i = 0; i < 4; ++i) O[i][qt] *= al;
#pragma unroll
            for (int ksx = 0; ksx < 2; ++ksx) { u32x4 pk; pk.x = pack2bf(pv[2 * ksx][0], pv[2 * ksx][1]); pk.y = pack2bf(pv[2 * ksx][2], pv[2 * ksx][3]);
                pk.z = pack2bf(pv[2 * ksx + 1][0], pv[2 * ksx + 1][1]); pk.w = pack2bf(pv[2 * ksx + 1][2], pv[2 * ksx + 1][3]); pf[qt][ksx] = __builtin_bit_cast(bf16x8, pk); }
        }
#pragma unroll
        for (int dvt = 0; dvt < 4; ++dvt)
#pragma unroll
            for (int ksx = 0; ksx < 2; ++ksx) {
                const int q4 = (lane & 15) >> 2, p4 = lane & 3;
                const char* a0 = vs + (32 * ksx + 4 * g + q4) * AT_ROWB + (16 * dvt + 4 * p4) * 2;
                const s16x4 v0 = __builtin_amdgcn_ds_read_tr16_b64_v4i16((__attribute__((address_space(3))) s16x4*)(a0));
                const s16x4 v1 = __builtin_amdgcn_ds_read_tr16_b64_v4i16((__attribute__((address_space(3))) s16x4*)(a0 + 16 * AT_ROWB));
                bf16x8 va; va[0] = v0[0]; va[1] = v0[1]; va[2] = v0[2]; va[3] = v0[3]; va[4] = v1[0]; va[5] = v1[1]; va[6] = v1[2]; va[7] = v1[3];
#pragma unroll
                for (int qt = 0; qt < 2; ++qt) O[dvt][qt] = __builtin_amdgcn_mfma_f32_16x16x32_bf16(va, pf[qt][ksx], O[dvt][qt], 0, 0, 0);
            }
        }
        if (ti + 1 < u.ntiles) attn_write(p, u, kp0n, tid, rk, rv, stg + ((ti + 1) & 1) * AT_STAGE);
        kp0 = kp0n;
        __syncthreads();
    }
#pragma unroll
    for (int qt = 0; qt < 2; ++qt) {
        float lt = l[qt]; lt += shfl_xor_f(lt, 16); lt += shfl_xor_f(lt, 32);
        if (u.has_sink) lt += __expf(u.sink - m[qt]);
        const float inv = __builtin_amdgcn_rcpf(lt); const int qi = 32 * w + 16 * qt + c; bf16_t* yr = p.Y + (size_t)(u.qrow0 + qi) * 512 + u.ycol;
#pragma unroll
        for (int dvt = 0; dvt < 4; ++dvt) { uint2 o; o.x = pack2bf(O[dvt][qt][0] * inv, O[dvt][qt][1] * inv); o.y = pack2bf(O[dvt][qt][2] * inv, O[dvt][qt][3] * inv); *(uint2*)(yr + 16 * dvt + 4 * g) = o; }
    }
}
constexpr int N_HG = BATCH * 8, N_UB = BATCH * 4 * (ROWS / 2), N_UA = BATCH * 4 * (SEQ / 128), N_UC = BATCH * 8 * (CTXL / 128);
DEV void attn_decode(const Params& p, int layer, int item, AttnUnit& u) {
    u.rope = false; u.has_sink = false; u.sink = 0.f; u.rp = 0; int nloc = 0;
    if (item < N_UB) {
        const int rp = item % (ROWS / 2), h = (item / (ROWS / 2)) % 4, b = item / (ROWS / 2 * 4);
        u.type = 1; u.b = b; u.h = h; u.qrow0 = b * TPB + CTXL + rp * 128; u.qpos0 = rp * 128;
        u.qcol = C_BQ + h * 64; u.kcol = C_BK + h * 64; u.vcol = C_BV + h * 64; u.ycol = 256 + h * 64;
        const int r0 = clampi(2 * rp - 4, 0, ROWS - 8), r1 = clampi(2 * rp + 1 - 4, 0, ROWS - 8) + 7;
        nloc = r1 - r0 + 1; u.rp = r0 * 64 - u.qpos0;
    } else if (item < N_UB + N_UA) {
        const int it = item - N_UB; const int blk = it % (SEQ / 128), h = (it / (SEQ / 128)) % 4, b = it / (SEQ / 128 * 4);
        u.type = 0; u.b = b; u.h = h; u.qrow0 = b * TPB + CTXL + blk * 128; u.qpos0 = blk * 128; u.rope = true;
        u.qcol = C_AQ + h * 64; u.kcol = C_AK + (h >> 1) * 64; u.vcol = C_AV + (h >> 1) * 64; u.ycol = h * 64; u.has_sink = true; u.sink = p.attn_sink[layer * 4 + h];
        const int k0 = (blk * 128 - 128 < 0) ? 0 : blk * 128 - 128, k1 = (blk * 128 + 256 > SEQ) ? SEQ : blk * 128 + 256;
        nloc = (k1 - k0) / 64; u.rp = k0 - u.qpos0;
    } else {
        const int it = item - N_UB - N_UA; const int qb = it % (CTXL / 128), h = (it / (CTXL / 128)) % 4, wh = (it / (CTXL / 128 * 4)) % 2, b = it / (CTXL / 128 * 8);
        u.type = 2; u.b = b; u.h = h; u.qrow0 = b * TPB + qb * 128; u.qpos0 = 0;
        if (wh) { u.qcol = C_BQ + h * 64; u.kcol = C_BK + h * 64; u.vcol = C_BV + h * 64; u.ycol = 256 + h * 64; }
        else { u.qcol = C_AQ + h * 64; u.kcol = C_AK + (h >> 1) * 64; u.vcol = C_AV + (h >> 1) * 64; u.ycol = h * 64; u.has_sink = true; u.sink = p.attn_sink[layer * 4 + h]; }
    }
    u.ntiles = nloc + CTXL / 64;
}
constexpr float U8_SCALE = 512.0f, V8_SCALE = 64.0f;
DEV unsigned pk4_fp8(float a, float b, float c, float d, float sc) {
    a = fminf(fmaxf(a * sc, -448.f), 448.f); b = fminf(fmaxf(b * sc, -448.f), 448.f); c = fminf(fmaxf(c * sc, -448.f), 448.f); d = fminf(fmaxf(d * sc, -448.f), 448.f);
    int r = __builtin_amdgcn_cvt_pk_fp8_f32(a, b, 0, false); r = __builtin_amdgcn_cvt_pk_fp8_f32(c, d, r, true); return (unsigned)r;
}
constexpr float U4_SCALE = 64.0f, V4_SCALE = 5.657f;
DEV unsigned pk8_fp4(const float4& a, const float4& b, float sc) {
    const float v[8] = {a.x, a.y, a.z, a.w, b.x, b.y, b.z, b.w}; unsigned r = 0u; float c[8];
#pragma unroll
    for (int j = 0; j < 8; ++j) c[j] = fminf(fmaxf(v[j] * sc, -6.f), 6.f);
    r = __builtin_amdgcn_cvt_scalef32_pk_fp4_f32(r, c[0], c[1], 1.0f, 0); r = __builtin_amdgcn_cvt_scalef32_pk_fp4_f32(r, c[2], c[3], 1.0f, 1);
    r = __builtin_amdgcn_cvt_scalef32_pk_fp4_f32(r, c[4], c[5], 1.0f, 2); r = __builtin_amdgcn_cvt_scalef32_pk_fp4_f32(r, c[6], c[7], 1.0f, 3);
    return r;
}
DEV void unpack16_fp4(const uint2& r, float* x) {
    const unsigned w[2] = {r.x, r.y};
#pragma unroll
    for (int q = 0; q < 2; ++q) {
        const f32x2 a = __builtin_amdgcn_cvt_scalef32_pk_f32_fp4(w[q], 1.0f, 0), b = __builtin_amdgcn_cvt_scalef32_pk_f32_fp4(w[q], 1.0f, 1),
                    c = __builtin_amdgcn_cvt_scalef32_pk_f32_fp4(w[q], 1.0f, 2), d = __builtin_amdgcn_cvt_scalef32_pk_f32_fp4(w[q], 1.0f, 3);
        x[8 * q] = a.x; x[8 * q + 1] = a.y; x[8 * q + 2] = b.x; x[8 * q + 3] = b.y; x[8 * q + 4] = c.x; x[8 * q + 5] = c.y; x[8 * q + 6] = d.x; x[8 * q + 7] = d.y; }
}
constexpr int N_UV = 256;
DEV void uvconv8_chunk(const Params& p, int layer, int chunk) {
    const int tid = otid();
    const float4* u = (const float4*)(p.peer_u + (size_t)layer * NEXP * DM); const float4* v = (const float4*)(p.peer_v + (size_t)layer * NEXP * DM);
    constexpr long PER = (long)NEXP * DM / 16 / N_UV;
    for (long i = (long)chunk * PER + tid; i < (long)(chunk + 1) * PER; i += 256) {
        uint2 a, b;
        { const float4 x0 = u[4 * i], x1 = u[4 * i + 1], x2 = u[4 * i + 2], x3 = u[4 * i + 3]; a.x = pk8_fp4(x0, x1, U4_SCALE); a.y = pk8_fp4(x2, x3, U4_SCALE); }
        { const float4 x0 = v[4 * i], x1 = v[4 * i + 1], x2 = v[4 * i + 2], x3 = v[4 * i + 3]; b.x = pk8_fp4(x0, x1, V4_SCALE); b.y = pk8_fp4(x2, x3, V4_SCALE); }
        ((uint2*)p.U8)[i] = a; ((uint2*)p.V8)[i] = b;
    }
}
DEV void st_mixers(const Params& p, int layer, char* smem, int* ticket) {
    const int natt = N_UB + N_UA + (layer == 0 ? N_UC : 0);
    const int total = N_HG + natt + N_UV;
    int* slot = (int*)(smem + 65536 + 32);
    for (;;) {
        __syncthreads();
        if (threadIdx.x == 0) *slot = atomicAdd(ticket, 1);
        __syncthreads();
        const int item = __builtin_amdgcn_readfirstlane(*slot);
        if (item >= total) break;
        if (item < N_HG) st_hgrn_mfma(p, layer, smem, item);
        else if (item < N_HG + natt) { AttnUnit u; attn_decode(p, layer, item - N_HG, u); attn_unit(p, layer, u, smem); }
        else uvconv8_chunk(p, layer, item - N_HG - natt);
    }
}
DEV void unpack16_fp8(const u32x4& r, float* x) {
    const unsigned w[4] = {r.x, r.y, r.z, r.w};
#pragma unroll
    for (int q = 0; q < 4; ++q) { const f32x2 lo = __builtin_amdgcn_cvt_pk_f32_fp8((int)w[q], false), hi = __builtin_amdgcn_cvt_pk_f32_fp8((int)w[q], true); x[4 * q] = lo.x; x[4 * q + 1] = lo.y; x[4 * q + 2] = hi.x; x[4 * q + 3] = hi.y; }
}
typedef int v8i_t __attribute__((ext_vector_type(8)));
typedef int v2i_t __attribute__((ext_vector_type(2)));
constexpr float X4_SCALE = 0.25f;
DEV void st_peer_expert_fused(const Params& p, int layer, bool lat_only, char* smem) {
    const int tid = otid(), lane = tid & 63, w = tid >> 6;
    char* wl = smem + w * 14336;
    int* idxs = (int*)wl; float* gates = (float*)(wl + 1024); unsigned char* xq = (unsigned char*)(wl + 2048); char* Tb = wl + 5120; char* At = wl + 5120 + 8448;
    int* itab = (int*)Tb + (lane & 15) * 32;
    const int ngroups = (lat_only ? NLAT : NTOK) / 8; const bool last = (layer == DEPTH - 1);
    for (int grp = blockIdx.x; grp < ngroups; grp += gridDim.x) {
        if (lane < 16) {
            const int tl = lane >> 3, h = lane & 7; const int r = grp * 8 + w * 2 + tl; const int row = lat_only ? lat_row(r) : r;
            const float* v1 = p.CANDV + ((size_t)row * 16 + h * 2) * 16; const float* v2 = v1 + 16; const int* i1 = p.CANDI + ((size_t)row * 16 + h * 2) * 16; const int* i2 = i1 + 16;
            float a1[16], a2[16];
#pragma unroll
            for (int j = 0; j < 16; ++j) { a1[j] = v1[j]; a2[j] = v2[j]; itab[j] = i1[j]; itab[16 + j] = i2[j]; }
            float V[16];
#pragma unroll
            for (int j = 0; j < 16; ++j) V[j] = -3.0e38f;
            CombKey<0, 0>::run(V, a1, a2);
            float sum = 0.f, e[16];
#pragma unroll
            for (int j = 0; j < 16; ++j) { e[j] = __expf(u2f(f2u(V[j]) & ~0xFFu) - u2f(f2u(V[0]) & ~0xFFu)); sum += e[j]; }
            const float inv = __builtin_amdgcn_rcpf(sum);
#pragma unroll
            for (int j = 0; j < 16; ++j) { const unsigned code = f2u(V[j]) & 0xFFu; idxs[tl * 128 + h * 16 + j] = itab[code >> 4] * NKEYS + itab[16 + (code & 15u)]; gates[tl * 128 + h * 16 + j] = e[j] * inv; }
        }
#pragma unroll 1
        for (int tt = 0; tt < 2; ++tt) {
            const int tok = tt; const int r = grp * 8 + w * 2 + tt; const int row = lat_only ? lat_row(r) : r;
            const int dgl = lane & 15, gq = lane >> 4;
            bf16_t* xb16 = p.RB + (size_t)row * DM + 16 * lane;
            const u32x4 rb0 = *(const u32x4*)xb16, rb1 = *(const u32x4*)(xb16 + 8);
            { float rr[16];
              { float hf[16]; const bf16_t* hp = p.H + (size_t)row * DM + 16 * lane; const u32x4 h0 = *(const u32x4*)hp, h1 = *(const u32x4*)(hp + 8); unpack8(h0, hf); unpack8(h1, hf + 8);
#pragma unroll
                for (int k = 0; k < 16; ++k) rr[k] = hf[k] * X4_SCALE; }
#pragma unroll
              for (int lv = 0; lv < 6; ++lv) {
                  unsigned wq[2];
#pragma unroll
                  for (int q = 0; q < 2; ++q) {
                      float cq[8];
#pragma unroll
                      for (int k = 0; k < 8; ++k) cq[k] = fminf(fmaxf(rr[8 * q + k], -6.f), 6.f);
                      unsigned wv = 0u;
                      wv = __builtin_amdgcn_cvt_scalef32_pk_fp4_f32(wv, cq[0], cq[1], 1.0f, 0); wv = __builtin_amdgcn_cvt_scalef32_pk_fp4_f32(wv, cq[2], cq[3], 1.0f, 1);
                      wv = __builtin_amdgcn_cvt_scalef32_pk_fp4_f32(wv, cq[4], cq[5], 1.0f, 2); wv = __builtin_amdgcn_cvt_scalef32_pk_fp4_f32(wv, cq[6], cq[7], 1.0f, 3);
                      wq[q] = wv;
                      if (lv < 5) {
                          const f32x2 b0 = __builtin_amdgcn_cvt_scalef32_pk_f32_fp4(wv, 1.0f, 0), b1 = __builtin_amdgcn_cvt_scalef32_pk_f32_fp4(wv, 1.0f, 1),
                                      b2 = __builtin_amdgcn_cvt_scalef32_pk_f32_fp4(wv, 1.0f, 2), b3 = __builtin_amdgcn_cvt_scalef32_pk_f32_fp4(wv, 1.0f, 3);
                          rr[8 * q] = (rr[8 * q] - b0.x) * 4.f; rr[8 * q + 1] = (rr[8 * q + 1] - b0.y) * 4.f; rr[8 * q + 2] = (rr[8 * q + 2] - b1.x) * 4.f; rr[8 * q + 3] = (rr[8 * q + 3] - b1.y) * 4.f;
                          rr[8 * q + 4] = (rr[8 * q + 4] - b2.x) * 4.f; rr[8 * q + 5] = (rr[8 * q + 5] - b2.y) * 4.f; rr[8 * q + 6] = (rr[8 * q + 6] - b3.x) * 4.f; rr[8 * q + 7] = (rr[8 * q + 7] - b3.y) * 4.f;
                      }
                  }
                  *(uint2*)(xq + 512 * lv + 8 * lane) = (uint2){wq[0], wq[1]};
              }
            }
            const unsigned char* xb = xq + 512 * (dgl < 6 ? dgl : 0) + 16 * gq;
            const float wlev = (dgl < 6) ? __builtin_amdgcn_ldexpf(1.0f, -2 * dgl) : 0.f;
            float accT[16];
#pragma unroll
            for (int n = 0; n < 16; ++n) accT[n] = 0.f;
            const int* idx = idxs + tok * 128; const float* gate = gates + tok * 128;
            uint2 vr[32];
#pragma unroll
            for (int j = 0; j < 32; ++j) { const int id = __builtin_amdgcn_readfirstlane(idx[j]); vr[j] = *(const uint2*)(p.V8 + (size_t)id * (DM / 2) + 8 * lane); }
#pragma unroll 1
            for (int e0 = 0; e0 < PE; e0 += 32) {
                float avg[2];
#pragma unroll
                for (int hg = 0; hg < 2; ++hg) {
                    const unsigned char* urow = p.U8 + (size_t)idx[e0 + 16 * hg + dgl] * (DM / 2) + 16 * gq;
                    f32x4 dd = (f32x4){0.f, 0.f, 0.f, 0.f};
#pragma unroll
                    for (int mh = 0; mh < 2; ++mh) {
                        u32x4 ua[4];
#pragma unroll
                        for (int m = 0; m < 4; ++m) ua[m] = *(const u32x4*)(urow + 64 * (4 * mh + m));
#pragma unroll
                        for (int m = 0; m < 4; ++m)
                          { const u32x4 bq = *(const u32x4*)(xb + 64 * (4 * mh + m));
                            dd = __builtin_amdgcn_mfma_scale_f32_16x16x128_f8f6f4((v8i_t){(int)ua[m].x, (int)ua[m].y, (int)ua[m].z, (int)ua[m].w, 0, 0, 0, 0},
                                     (v8i_t){(int)bq.x, (int)bq.y, (int)bq.z, (int)bq.w, 0, 0, 0, 0}, dd, 4, 4, 0, 0x7f7f7f7f, 0, 0x7f7f7f7f); }
                    }
                    float t;
                    { float s4[4];
#pragma unroll
                      for (int r = 0; r < 4; ++r) s4[r] = row16_sum(dd[r] * wlev);
                      const int src = 16 * (dgl >> 2);
                      const float t0 = __shfl(s4[0], src, 64), t1 = __shfl(s4[1], src, 64), t2 = __shfl(s4[2], src, 64), t3 = __shfl(s4[3], src, 64);
                      t = (dgl & 2) ? ((dgl & 1) ? t3 : t2) : ((dgl & 1) ? t1 : t0); }
                    avg[hg] = gate[e0 + 16 * hg + dgl] * gelu_fast(t * (1.0f / (U4_SCALE * X4_SCALE))) * (1.0f / V4_SCALE);
                }
                int sca; v8i_t aop;
                { const float avs = (gq & 1) ? avg[1] : avg[0];
                  float am = fabsf(avs); am = fmaxf(am, dppf<0x128>(am)); am = fmaxf(am, dppf<0x124>(am)); am = fmaxf(am, dppf<0x122>(am)); am = fmaxf(am, dppf<0x121>(am));
                  int es = (int)((f2u(am) >> 23) & 0xffu) - 127; es = es < -100 ? -100 : es;
                  float r = avs * __builtin_amdgcn_ldexpf(1.0f, 1 - es);
                  unsigned word = 0u;
#pragma unroll
                  for (int lv = 0; lv < 4; ++lv) {
                      const float cq = fminf(fmaxf(r, -6.f), 6.f);
                      const unsigned wv = __builtin_amdgcn_cvt_scalef32_pk_fp4_f32(0u, cq, cq, 1.0f, 0);
                      word |= (wv & 0xFu) << (4 * lv);
                      const f32x2 bk = __builtin_amdgcn_cvt_scalef32_pk_f32_fp4(wv, 1.0f, 0);
                      r = (r - bk.x) * 4.f; }
                  const unsigned rep = (gq < 2) ? word * 0x00010001u : 0u;
                  *(uint2*)(At + gq * 128 + dgl * 8) = (uint2){rep, rep};
                  sca = 127 + es - 1 - 2 * (dgl & 3); sca = sca < 0 ? 0 : (sca > 254 ? 254 : sca);
                  const v2i_t t2 = __builtin_amdgcn_ds_read_tr4_b64_v2i32((LAS v2i_t*)(At + gq * 128 + dgl * 8)); aop = (v8i_t){t2.x, t2.y, 0, 0, 0, 0, 0, 0}; }
                const char* trow = Tb + (dgl + 16 * (gq & 1)) * 264;
#pragma unroll
                for (int hf2 = 0; hf2 < 2; ++hf2) {
                    if ((lane >> 5) == hf2) {
#pragma unroll
                        for (int j = 0; j < 32; ++j) *(uint2*)(Tb + j * 264 + 8 * (lane & 31)) = vr[j];
                    }
                    if (hf2 == 1 && e0 + 32 < PE) {
#pragma unroll
                        for (int j = 0; j < 32; ++j) { const int id = __builtin_amdgcn_readfirstlane(idx[e0 + 32 + j]); vr[j] = *(const uint2*)(p.V8 + (size_t)id * (DM / 2) + 8 * lane); }
                    }
                    v2i_t tb[2][4];
#pragma unroll
                    for (int gg = 0; gg < 4; ++gg) tb[0][gg] = __builtin_amdgcn_ds_read_tr4_b64_v2i32((LAS v2i_t*)(trow + 8 * gg));
#pragma unroll
                    for (int m = 0; m < 8; ++m) {
                        if (m + 1 < 8) {
#pragma unroll
                            for (int gg = 0; gg < 4; ++gg) tb[(m + 1) & 1][gg] = __builtin_amdgcn_ds_read_tr4_b64_v2i32((LAS v2i_t*)(trow + 8 * (4 * (m + 1) + gg)));
                        }
                        f32x4 d4[4];
#pragma unroll
                        for (int gg = 0; gg < 4; ++gg)
                            d4[gg] = __builtin_amdgcn_mfma_scale_f32_16x16x128_f8f6f4(aop, __builtin_shufflevector(tb[m & 1][gg], tb[m & 1][gg], 0, 1, -1, -1, -1, -1, -1, -1), (f32x4){0.f, 0.f, 0.f, 0.f}, 4, 4, 0, sca, 0, 0x7f7f7f7f);
                        float sm4[4];
#pragma unroll
                        for (int gg = 0; gg < 4; ++gg) sm4[gg] = (d4[gg][0] + d4[gg][1]) + (d4[gg][2] + d4[gg][3]);
                        accT[8 * hf2 + m] += (gq & 2) ? ((gq & 1) ? sm4[3] : sm4[2]) : ((gq & 1) ? sm4[1] : sm4[0]);
                    }
                }
            }
            float acc[16];
            { float* tf = (float*)Tb;
#pragma unroll
              for (int n = 0; n < 16; ++n) tf[512 * (n >> 3) + 16 * (4 * (n & 7) + gq) + dgl] = accT[n];
#pragma unroll
              for (int q = 0; q < 4; ++q) { const float4 t4 = *(const float4*)(tf + 16 * lane + 4 * q); acc[4 * q] = t4.x; acc[4 * q + 1] = t4.y; acc[4 * q + 2] = t4.z; acc[4 * q + 3] = t4.w; } }
            const float* g2 = mod_row(p, layer, row) + 5 * DM + 16 * lane;
            float xn[16]; float ss = 0.f;
            { float xv[16]; unpack8(rb0, xv); unpack8(rb1, xv + 8);
#pragma unroll
              for (int q = 0; q < 4; ++q) { const float4 gg = *(const float4*)(g2 + 4 * q);
                  xn[4 * q] = xv[4 * q] + gg.x * acc[4 * q]; xn[4 * q + 1] = xv[4 * q + 1] + gg.y * acc[4 * q + 1]; xn[4 * q + 2] = xv[4 * q + 2] + gg.z * acc[4 * q + 2]; xn[4 * q + 3] = xv[4 * q + 3] + gg.w * acc[4 * q + 3]; } }
#pragma unroll
            for (int k = 0; k < 16; ++k) ss += xn[k] * xn[k];
            ss = wave_sum(ss); const float rs = rsq_fast(ss * (1.0f / DM) + EPS);
            if (last) {
                const float* fn = p.final_norm + 16 * lane; float* xr = resid_out(p, row) + 16 * lane;
                float4 fnv[4];
#pragma unroll
                for (int q = 0; q < 4; ++q) fnv[q] = *(const float4*)(fn + 4 * q);
#pragma unroll
                for (int q = 0; q < 4; ++q) { const float4 gg = fnv[q]; *(float4*)(xr + 4 * q) = (float4){xn[4 * q] * rs * gg.x, xn[4 * q + 1] * rs * gg.y, xn[4 * q + 2] * rs * gg.z, xn[4 * q + 3] * rs * gg.w}; }
            } else {
                const float* m = mod_row(p, layer + 1, row); const float* g = p.norm_mix + (size_t)(layer + 1) * DM + 16 * lane; const float* sh = m + 16 * lane; const float* sc = m + DM + 16 * lane;
                float4 ggv[4], s1v[4], s0v[4];
#pragma unroll
                for (int q = 0; q < 4; ++q) { ggv[q] = *(const float4*)(g + 4 * q); s1v[q] = *(const float4*)(sc + 4 * q); s0v[q] = *(const float4*)(sh + 4 * q); }
                *(u32x4*)xb16 = (u32x4){pack2bf(xn[0], xn[1]), pack2bf(xn[2], xn[3]), pack2bf(xn[4], xn[5]), pack2bf(xn[6], xn[7])};
                *(u32x4*)(xb16 + 8) = (u32x4){pack2bf(xn[8], xn[9]), pack2bf(xn[10], xn[11]), pack2bf(xn[12], xn[13]), pack2bf(xn[14], xn[15])};
                unsigned o[8];
#pragma unroll
                for (int q = 0; q < 4; ++q) { const float4 gg = ggv[q], s1 = s1v[q], s0 = s0v[q];
                    o[2 * q] = pack2bf(xn[4 * q] * rs * gg.x * (1.0f + s1.x) + s0.x, xn[4 * q + 1] * rs * gg.y * (1.0f + s1.y) + s0.y);
                    o[2 * q + 1] = pack2bf(xn[4 * q + 2] * rs * gg.z * (1.0f + s1.z) + s0.z, xn[4 * q + 3] * rs * gg.w * (1.0f + s1.w) + s0.w); }
                bf16_t* hp = p.H + (size_t)row * DM + 16 * lane;
                *(u32x4*)hp = (u32x4){o[0], o[1], o[2], o[3]}; *(u32x4*)(hp + 8) = (u32x4){o[4], o[5], o[6], o[7]};
            }
        }
    }
}
#define XB_TMO      128
#define XB_XCNT(j)  (256  + 64 * (j))
#define XB_XSUB(j)  (1280 + 64 * (j))
#define XB_XGEN(j)  (2304 + 64 * (j))
#define XB_TOP      3328
#define XB_TOPGEN   3392
#define XCD_BAR_WORDS 3456
#define XB_SPIN_CAP (1u << 18)

__device__ __forceinline__ unsigned xb_ld(unsigned* p)              { return __hip_atomic_load(p, __ATOMIC_RELAXED, __HIP_MEMORY_SCOPE_AGENT); }
__device__ __forceinline__ unsigned xb_add(unsigned* p, unsigned v) { return __hip_atomic_fetch_add(p, v, __ATOMIC_RELAXED, __HIP_MEMORY_SCOPE_AGENT); }
__device__ __forceinline__ unsigned xb_xcc_id() { return (unsigned)__builtin_amdgcn_s_getreg((3 << 11) | 20) & 0xFu; }
#define XB_SPIN(cond, bar) do { unsigned _sp = 0; while (cond) { __builtin_amdgcn_s_sleep(1); \
    if ((++_sp & 255u) == 0u) { if (xb_ld(&(bar)[XB_TMO])) break; if (_sp > XB_SPIN_CAP) { atomicAdd(&(bar)[XB_TMO], 1u); break; } } } } while (0)

struct XcdBarrier {
    unsigned* bar; unsigned x;
    volatile LAS unsigned* st;
};

__device__ __forceinline__ XcdBarrier xcd_barrier_post(unsigned* bar, volatile LAS unsigned* st) {
    XcdBarrier b; b.bar = bar; b.x = xb_xcc_id(); b.st = st;
    if (threadIdx.x == 0) (void)xb_add(&bar[XB_XCNT(b.x)], 1u);
    return b;
}
__device__ __forceinline__ void xcd_barrier_complete(unsigned* bar, unsigned x, unsigned& nloc, unsigned& nx) {
    const unsigned G = gridDim.x * gridDim.y * gridDim.z;
    unsigned sum, cnt, mine, sp = 0u;
    for (;;) {
        sum = 0u; cnt = 0u; mine = 0u;
#pragma unroll
        for (unsigned j = 0; j < 16; ++j) { const unsigned c = xb_ld(&bar[XB_XCNT(j)]); sum += c; cnt += (c > 0u) ? 1u : 0u; mine = (j == x) ? c : mine; }
        if (sum == G) break;
        __builtin_amdgcn_s_sleep(1);
        if ((++sp & 255u) == 0u) { if (xb_ld(&bar[XB_TMO])) break; if (sp > XB_SPIN_CAP) { atomicAdd(&bar[XB_TMO], 1u); break; } }
    }
    nloc = mine > 0u ? mine : 1u; nx = cnt > 0u ? cnt : 1u;
}

__device__ __forceinline__ void xcd_barrier(const XcdBarrier& b) {
    asm volatile("s_waitcnt vmcnt(0)" ::: "memory");
    __syncthreads();
    if (threadIdx.x == 0) {
        unsigned* bar = b.bar;
        __builtin_amdgcn_s_waitcnt(0);
        unsigned nloc = b.st[0], nx = b.st[1];
        if (nloc == 0u) { xcd_barrier_complete(bar, b.x, nloc, nx); b.st[0] = nloc; b.st[1] = nx; }
        const unsigned old = xb_add(&bar[XB_XSUB(b.x)], 1u);
        const unsigned gen = old / nloc;
        if (old + 1u == (gen + 1u) * nloc) {
            __builtin_amdgcn_fence(__ATOMIC_RELEASE, "agent");
            asm volatile("s_waitcnt vmcnt(0)" ::: "memory");
            const unsigned og = xb_add(&bar[XB_TOP], 1u);
            const unsigned tg = og / nx;
            if (og + 1u == (tg + 1u) * nx) xb_add(&bar[XB_TOPGEN], 1u);
            else XB_SPIN(xb_ld(&bar[XB_TOPGEN]) == tg, bar);
            __builtin_amdgcn_fence(__ATOMIC_ACQUIRE, "agent");
            xb_add(&bar[XB_XGEN(b.x)], 1u);
            asm volatile("s_waitcnt vmcnt(0)" ::: "memory");
        } else {
            XB_SPIN(xb_ld(&bar[XB_XGEN(b.x)]) == gen, bar);
            __builtin_amdgcn_fence(__ATOMIC_ACQUIRE, "agent");
            asm volatile("s_waitcnt vmcnt(0)" ::: "memory");
        }
    }
    __syncthreads();
}

DEV void st_mod_fast(const Params& p, char* smem) {
    const int tid = otid(), nl = tid & 31, kg = tid >> 5; float* tab = (float*)smem; float* red = (float*)(smem + 36864);
    for (int blk = blockIdx.x; blk < DEPTH * NMODW / 32; blk += gridDim.x) {
        const int l = blk / (NMODW / 32), n = (blk % (NMODW / 32)) * 32 + nl;
        const float* w = p.w_mod + (size_t)l * DM * NMODW + n;
        float acc[17];
#pragma unroll
        for (int r = 0; r < 17; ++r) acc[r] = 0.f;
        for (int kh = 0; kh < 2; ++kh) {
            __syncthreads();
            { float cvv[34];
#pragma unroll
              for (int i = 0; i < 34; ++i) { const int e = tid + 256 * i, r = e >> 9, k = kh * 512 + (e & 511); cvv[i] = (r < 16) ? p.c[(size_t)(r < BATCH ? r : 0) * DM + k] : p.c_ctx[k]; }
#pragma unroll
              for (int i = 0; i < 34; ++i) tab[tid + 256 * i] = silu_fast(cvv[i]); }
            __syncthreads();
            const float* wk = w + (size_t)(kh * 512 + kg * 64) * NMODW; const float* tk = tab + kg * 64;
            {
                float wv[64];
#pragma unroll
                for (int u = 0; u < 64; ++u) wv[u] = wk[(size_t)u * NMODW];
#pragma unroll
                for (int k8 = 0; k8 < 64; k8 += 8)
#pragma unroll
                    for (int r = 0; r < 17; ++r) { const float4 t0 = *(const float4*)(tk + r * 512 + k8), t1 = *(const float4*)(tk + r * 512 + k8 + 4);
                        acc[r] += t0.x * wv[k8] + t0.y * wv[k8 + 1] + t0.z * wv[k8 + 2] + t0.w * wv[k8 + 3] + t1.x * wv[k8 + 4] + t1.y * wv[k8 + 5] + t1.z * wv[k8 + 6] + t1.w * wv[k8 + 7]; }
            }
        }
#pragma unroll
        for (int r = 0; r < 17; ++r) red[(kg * 17 + r) * 32 + nl] = acc[r];
        __syncthreads();
        for (int e = tid; e < 17 * 32; e += 256) {
            const int r = e >> 5, c = e & 31; float sm = 0.f;
#pragma unroll
            for (int q = 0; q < 8; ++q) sm += red[(q * 17 + r) * 32 + c];
            const int nn = (blk % (NMODW / 32)) * 32 + c;
            p.MOD[((size_t)l * 17 + r) * NMODW + nn] = sm + p.b_mod[(size_t)l * NMODW + nn];
        }
    }
    __syncthreads();
}
DEV void wt_item_load(const Params& p, int item, int tid, float (&v)[16]) {
    constexpr int NT = (INW + DM + PQW) / 64, KT = DM / 64;
    const int l = item / (NT * KT), r = item % (NT * KT), nt = r / KT, kt = r % KT; const int n0 = nt * 64, k0 = kt * 64;
    const float* src; int ld, nn;
    if (n0 < INW) { src = p.w_in + (size_t)l * DM * INW; ld = INW; nn = n0; } else if (n0 < INW + DM) { src = p.w_out + (size_t)l * DM * DM; ld = DM; nn = n0 - INW; } else { src = p.peer_wq + (size_t)l * DM * PQW; ld = PQW; nn = n0 - INW - DM; }
#pragma unroll
    for (int i = 0; i < 16; ++i) { const int e = tid + 256 * i, kk = e >> 6, n = e & 63; v[i] = src[(size_t)(k0 + kk) * ld + nn + n]; }
}
DEV void st_wt_fast(const Params& p, char* smem) {
    const int tid = otid(); float* t = (float*)smem;
    constexpr int NT = (INW + DM + PQW) / 64, KT = DM / 64, NIT = DEPTH * NT * KT;
    float nx[16];
    if ((int)blockIdx.x < NIT) wt_item_load(p, blockIdx.x, tid, nx);
    for (int item = blockIdx.x; item < NIT; item += gridDim.x) {
        const int l = item / (NT * KT), r = item % (NT * KT), nt = r / KT, kt = r % KT; const int n0 = nt * 64, k0 = kt * 64;
        float cur[16];
#pragma unroll
        for (int i = 0; i < 16; ++i) cur[i] = nx[i];
        if (item + (int)gridDim.x < NIT) wt_item_load(p, item + gridDim.x, tid, nx);
        __syncthreads();
#pragma unroll
        for (int i = 0; i < 16; ++i) { const int e = tid + 256 * i, kk = e >> 6, n = e & 63; t[kk * 65 + n] = cur[i]; }
        __syncthreads();
        bf16_t* dst = p.WT + (size_t)l * WTL + (size_t)n0 * DM + k0;
#pragma unroll
        for (int i = 0; i < 8; ++i) { const int e = tid + 256 * i, n = e >> 5, k2 = (e & 31) * 2; *(unsigned*)(dst + (size_t)n * DM + k2) = pack2bf(t[k2 * 65 + n], t[(k2 + 1) * 65 + n]); }
    }
    const long gt = GT, gs = GS;
    for (long i = gt; i < (long)DEPTH * 2 * NKEYS * 128; i += gs) {
        const int l = (int)(i / (2 * NKEYS * 128)); const int e = (int)(i % (2 * NKEYS * 128)); const int hf = e / (NKEYS * 128), r = e % (NKEYS * 128);
        p.KB[i] = f2bf((hf ? p.peer_k2 : p.peer_k1)[(size_t)l * NKEYS * 128 + r]);
    }
    for (long i = gt; i < 64 * 16; i += gs) {
        const int pos = (int)(i / 16), f = (int)(i % 16);
        const float inv = powf(10000.0f, -((float)(2 * f)) / 32.0f); const float ang = (float)pos * inv;
        p.ROPE[i] = cosf(ang); p.ROPE[1024 + i] = sinf(ang);
    }
}

__global__ void __launch_bounds__(256, 2) __attribute__((target("no-packed-fp32-ops"))) mega(Params p) {
    __shared__ __attribute__((aligned(16))) char smem[65536 + 64];
    const long gs = GS; const int bid = blockIdx.x, nb = gridDim.x;
    if (threadIdx.x < 4) ((volatile LAS unsigned*)(smem + 65536))[threadIdx.x] = 0u;
    __syncthreads();
    const XcdBarrier xb = xcd_barrier_post(p.BAR, (volatile LAS unsigned*)(smem + 65536));
    st_mod_fast(p, smem); st_wt_fast(p, smem);
    xcd_barrier(xb);
    st_norm_fast(p, 0, 0, false);
    xcd_barrier(xb);
    for (int l = 0; l < DEPTH; ++l) {
        const bool last = (l == DEPTH - 1);
        if (last) { st_gemm_mfma(p, l, 0, true, smem, bid, nb); st_gemm_ctx_last(p, l, smem, bid, nb); }
        else st_gemm_mfma(p, l, 0, false, smem, bid, nb);
        xcd_barrier(xb);
        st_mixers(p, l, smem, p.TICKET + l);
        xcd_barrier(xb);
        st_merge_fast(p, l, last);
        xcd_barrier(xb);
        st_gemm_mfma(p, l, 1, last, smem, bid, nb);
        xcd_barrier(xb);
        st_norm2_fast(p, l, last);
        xcd_barrier(xb);
        st_gemm_mfma(p, l, 2, last, smem, bid, nb);
        xcd_barrier(xb);
        st_peer_expert_fused(p, l, last, smem);
        if (!last) xcd_barrier(xb);
    }
}

extern "C" void kernel_launch(void* const* d_in, const int* in_sizes, int n_in, void* d_out, int out_size, void* d_ws, size_t ws_size, hipStream_t stream) {
    static int grid_blocks = 0;
    if (!grid_blocks) {
        int dev = 0, cus = 0, per_cu = 0;
        hipGetDevice(&dev);
        hipDeviceGetAttribute(&cus, hipDeviceAttributeMultiprocessorCount, dev);
        hipOccupancyMaxActiveBlocksPerMultiprocessor(&per_cu, mega, 256, 0);
        if (per_cu > 2) per_cu = 2;
        if (per_cu < 1) per_cu = 1;
        grid_blocks = cus * per_cu;
    }
    Params p = make_params(d_in, d_out, d_ws);
    hipMemsetAsync((void*)p.TICKET, 0, 256 + XCD_BAR_WORDS * 4, stream);
    void* args[] = {&p};
    hipError_t e = hipLaunchCooperativeKernel((void*)mega, dim3(grid_blocks), dim3(256), args, 0, stream);
    if (e != hipSuccess) fprintf(stderr, "cooperative launch failed: %s (grid %d)\n", hipGetErrorString(e), grid_blocks);
}
#endif
```
